# Optimizing an MI355X kernel written in HIP

```python
import numpy as np
import jax
import jax.numpy as jnp
from jax import lax

D_MODEL = 1024
BATCH = 4
SEQ = 4096
DEPTH = 2
DEC_BATCH = 32
DEC_SEQ = 1
PAST_LEN = 8192
PAGE_SIZE = 128

HEAD_DIM = 64
BRANCH_W = D_MODEL // 2
N_HEADS = BRANCH_W // HEAD_DIM
N_KV = N_HEADS // 4
GROUP = N_HEADS // N_KV
ROT_DIM = HEAD_DIM // 4
ROPE_THETA = 500000.0
CMP_LEN = 32
CMP_STRIDE = 16
CMP_RATIO = CMP_LEN // CMP_STRIDE
CMP_HIDDEN = 2 * HEAD_DIM
SLC_BLOCK = 64
N_SELECT = 16
WINDOW = 512
Q_BLOCK = 128
CONV_CH = BRANCH_W
CONV_W = 3
MEM_LEN = 256
MEM_HEADS = 4
MEM_HEAD_DIM = BRANCH_W // MEM_HEADS
N_BRANCH = 3
D_FF = ((8 * D_MODEL + 767) // 768) * 256
N_IN = N_HEADS * HEAD_DIM + 6 * N_KV * HEAD_DIM + 3 * N_HEADS + 3 * CONV_CH + MEM_HEADS * MEM_HEAD_DIM + N_BRANCH * D_MODEL
EPS = 1e-6

kernel_name = 'nsa_shortconv_memxattn_hybrid_step'


def rmsnorm(x, g):
    xf = x.astype(jnp.float32)
    y = xf * lax.rsqrt(jnp.mean(xf * xf, axis=-1, keepdims=True) + EPS)
    return (y * g.astype(jnp.float32)).astype(x.dtype)


def rope(x, pos):
    half = ROT_DIM // 2
    inv = ROPE_THETA ** (-jnp.arange(half, dtype=jnp.float32) / half)
    ang = pos.astype(jnp.float32)[:, None] * inv[None, :]
    cos = jnp.cos(ang)[:, None, :]
    sin = jnp.sin(ang)[:, None, :]
    xr = x[..., :ROT_DIM].astype(jnp.float32)
    x1, x2 = xr[..., :half], xr[..., half:]
    rot = jnp.concatenate([x1 * cos - x2 * sin, x2 * cos + x1 * sin], axis=-1)
    return jnp.concatenate([rot.astype(x.dtype), x[..., ROT_DIM:]], axis=-1)


def masked_softmax(s, mask):
    s = jnp.where(mask, s.astype(jnp.float32), -1e30)
    return jnp.where(mask, jax.nn.softmax(s, axis=-1), 0.0)


def split_in(h):
    sizes = [N_HEADS * HEAD_DIM, 6 * N_KV * HEAD_DIM, 3 * N_HEADS, CONV_CH, CONV_CH, CONV_CH,
             MEM_HEADS * MEM_HEAD_DIM]
    return jnp.split(h, np.cumsum(sizes).tolist(), axis=-1)


def prep(x, pos, p):
    B, T, _ = x.shape
    xn = rmsnorm(x, p['norm_mix'])
    h = jnp.einsum('btd,de->bte', xn, p['w_in'])
    q, kv, ng, cx, cb, cc, mq, mg = split_in(h)
    q = rmsnorm(q.reshape(B, T, N_HEADS, HEAD_DIM), p['q_norm'])
    kv = kv.reshape(B, T, 3, 2, N_KV, HEAD_DIM)
    k_slc = rope(rmsnorm(kv[:, :, 1, 0], p['k_norm'][1]), pos)
    k_win = rope(rmsnorm(kv[:, :, 2, 0], p['k_norm'][2]), pos)
    return dict(
        q=q, q_rot=rope(q, pos),
        rows=jnp.stack([kv[:, :, 0, 0], kv[:, :, 0, 1], k_slc, kv[:, :, 1, 1]], axis=2),
        win=jnp.stack([k_win, kv[:, :, 2, 1]], axis=2),
        ng=jax.nn.sigmoid(ng).reshape(B, T, 3, N_HEADS),
        u=cc * cx, cb=cb,
        mq=rmsnorm(mq.reshape(B, T, MEM_HEADS, MEM_HEAD_DIM), p['mem_q_norm']),
        mg=jax.nn.sigmoid(mg).reshape(B, T, N_BRANCH, D_MODEL))


def compress(rows, pe, w1, w2):
    B, T = rows.shape[:2]
    n_sub = T // CMP_STRIDE
    nc = n_sub - CMP_RATIO + 1
    sub = rows[:, :n_sub * CMP_STRIDE].reshape(B, n_sub, CMP_STRIDE, N_KV, HEAD_DIM)
    w1r = w1.reshape(CMP_RATIO, CMP_STRIDE, HEAD_DIM, CMP_HIDDEN)
    per = pe.reshape(CMP_RATIO, CMP_STRIDE, 1, HEAD_DIM)
    h = jnp.einsum('bnsgd,sdh->bngh', sub[:, :nc] + per[0], w1r[0])
    for r in range(1, CMP_RATIO):
        h = h + jnp.einsum('bnsgd,sdh->bngh', sub[:, r:r + nc] + per[r], w1r[r])
    return jnp.einsum('bngh,he->bnge', jax.nn.silu(h), w2)


def compress_kv(k_raw, v_raw, p):
    kc = rmsnorm(compress(k_raw, p['cmp_pe'][0], p['cmp_w1'][0], p['cmp_w2'][0]), p['k_norm'][0])
    vc = compress(v_raw, p['cmp_pe'][1], p['cmp_w1'][1], p['cmp_w2'][1])
    return kc, vc


def cmp_attend(q, q_pos, kc, vc):
    B, Tq = q.shape[:2]
    nc = kc.shape[1]
    ends = jnp.arange(nc) * CMP_STRIDE + CMP_LEN - 1
    mask = ends[None, :] <= q_pos[:, None]
    qg = q.reshape(B, Tq, N_KV, GROUP, HEAD_DIM)
    s = jnp.einsum('bqghd,bcgd->bqghc', qg, kc) * HEAD_DIM ** -0.5
    pr = masked_softmax(s, mask[None, :, None, None, :])
    o = jnp.einsum('bqghc,bcgd->bqghd', pr.astype(vc.dtype), vc)
    return o.reshape(B, Tq, N_HEADS, HEAD_DIM), jnp.sum(pr, axis=3)


def select_blocks(imp, q_pos, n_keys):
    nc = imp.shape[-1]
    ns = -(-n_keys // SLC_BLOCK)
    i = jnp.arange(nc)[:, None]
    j = jnp.arange(ns)[None, :]
    overlap = ((i * CMP_STRIDE < (j + 1) * SLC_BLOCK) & (i * CMP_STRIDE + CMP_LEN > j * SLC_BLOCK)).astype(jnp.float32)
    score = jnp.einsum('bqgc,cs->bqgs', imp.astype(jnp.float32), overlap)
    qb = (q_pos // SLC_BLOCK)[:, None]
    forced = (j == 0) | (j == qb) | (j == qb - 1)
    eligible = j * SLC_BLOCK <= q_pos[:, None]
    score = jnp.where(forced[None, :, None, :], jnp.inf,
                      jnp.where(eligible[None, :, None, :], score, -jnp.inf))
    _, idx = lax.top_k(score, min(N_SELECT, ns))
    return idx


def attend_gathered(q, q_pos, k, v, k_pos):
    B, Tq = q.shape[:2]
    qg = q.reshape(B, Tq, N_KV, GROUP, HEAD_DIM)
    s = jnp.einsum('bqghd,bqgkd->bqghk', qg, k) * HEAD_DIM ** -0.5
    mask = (k_pos <= q_pos[None, :, None, None])[:, :, :, None, :]
    pr = masked_softmax(s, mask)
    o = jnp.einsum('bqghk,bqgkd->bqghd', pr.astype(v.dtype), v)
    return o.reshape(B, Tq, N_HEADS, HEAD_DIM)


def window_attend(q, q_pos, k, v, k_pos):
    B, Tq = q.shape[:2]
    qg = q.reshape(B, Tq, N_KV, GROUP, HEAD_DIM)
    s = jnp.einsum('bqghd,bkgd->bqghk', qg, k) * HEAD_DIM ** -0.5
    d = q_pos[:, None] - k_pos[None, :]
    mask = (d >= 0) & (d < WINDOW) & (k_pos[None, :] >= 0)
    pr = masked_softmax(s, mask[None, :, None, None, :])
    o = jnp.einsum('bqghk,bkgd->bqghd', pr.astype(v.dtype), v)
    return o.reshape(B, Tq, N_HEADS, HEAD_DIM)


def merge_blocks(o):
    nb, B, qb = o.shape[:3]
    return jnp.moveaxis(o, 0, 1).reshape(B, nb * qb, N_HEADS, HEAD_DIM)


def combine_nsa(ng, o_c, o_s, o_w):
    o = ng[:, :, 0, :, None] * o_c + ng[:, :, 1, :, None] * o_s + ng[:, :, 2, :, None] * o_w
    return o.reshape(o.shape[0], o.shape[1], N_HEADS * HEAD_DIM)


def nsa_prompt(t, p):
    q, q_rot, rows = t['q'], t['q_rot'], t['rows']
    B, T = q.shape[:2]
    pos = jnp.arange(T)
    kc, vc = compress_kv(rows[:, :, 0], rows[:, :, 1], p)
    o_c, imp = cmp_attend(q, pos, kc, vc)
    idx = select_blocks(imp, pos, T)
    k_s, v_s = rows[:, :, 2], rows[:, :, 3]
    bi = jnp.arange(B)[:, None, None, None]
    gi = jnp.arange(N_KV)[None, None, :, None]
    offs = jnp.arange(SLC_BLOCK)
    starts = jnp.arange(T // Q_BLOCK) * Q_BLOCK

    def slc_block(start):
        qb = lax.dynamic_slice_in_dim(q_rot, start, Q_BLOCK, 1)
        ib = lax.dynamic_slice_in_dim(idx, start, Q_BLOCK, 1)
        kpos = (ib[..., None] * SLC_BLOCK + offs).reshape(B, Q_BLOCK, N_KV, -1)
        kposc = jnp.minimum(kpos, T - 1)
        return attend_gathered(qb, start + jnp.arange(Q_BLOCK), k_s[bi, kposc, gi], v_s[bi, kposc, gi], kpos)

    o_s = merge_blocks(lax.map(slc_block, starts))
    wp = jnp.pad(t['win'], ((0, 0), (WINDOW, 0), (0, 0), (0, 0), (0, 0)))

    def win_block(start):
        qb = lax.dynamic_slice_in_dim(q_rot, start, Q_BLOCK, 1)
        kvb = lax.dynamic_slice_in_dim(wp, start, WINDOW + Q_BLOCK, 1)
        kpos = start - WINDOW + jnp.arange(WINDOW + Q_BLOCK)
        return window_attend(qb, start + jnp.arange(Q_BLOCK), kvb[:, :, 0], kvb[:, :, 1], kpos)

    o_w = merge_blocks(lax.map(win_block, starts))
    return combine_nsa(t['ng'], o_c, o_s, o_w)


def nsa_sample(t, pool, layer, win_buf, page_table, p):
    q, q_rot, rows = t['q'], t['q_rot'], t['rows']
    B, Tn = q.shape[:2]
    n_pages = page_table.shape[1]
    pos = PAST_LEN + jnp.arange(Tn)
    past_c = pool[layer, page_table, :, :2].reshape(B, PAST_LEN, 2, N_KV, HEAD_DIM)
    full_c = jnp.concatenate([past_c, rows[:, :, :2]], axis=1)
    kc, vc = compress_kv(full_c[:, :, 0], full_c[:, :, 1], p)
    o_c, imp = cmp_attend(q, pos, kc, vc)
    idx = select_blocks(imp, pos, PAST_LEN + Tn)
    bi = jnp.arange(B)[:, None, None, None]
    gi = jnp.arange(N_KV)[None, None, :, None]
    kpos = (idx[..., None] * SLC_BLOCK + jnp.arange(SLC_BLOCK)).reshape(B, Tn, N_KV, -1)
    phys = page_table[bi, jnp.minimum(kpos // PAGE_SIZE, n_pages - 1)]
    off = kpos % PAGE_SIZE
    rel = jnp.clip(kpos - PAST_LEN, 0, Tn - 1)
    is_past = (kpos < PAST_LEN)[..., None]
    k_s = jnp.where(is_past, pool[layer, phys, off, 2, gi], rows[bi, rel, 2, gi])
    v_s = jnp.where(is_past, pool[layer, phys, off, 3, gi], rows[bi, rel, 3, gi])
    o_s = attend_gathered(q_rot, pos, k_s, v_s, kpos)
    w_buf = win_buf.shape[1]
    wfull = jnp.concatenate([win_buf, t['win']], axis=1)
    kpos_w = PAST_LEN - w_buf + jnp.arange(w_buf + Tn)
    o_w = window_attend(q_rot, pos, wfull[:, :, 0], wfull[:, :, 1], kpos_w)
    return combine_nsa(t['ng'], o_c, o_s, o_w), wfull[:, -w_buf:]


def dwconv(u_ext, w):
    T = u_ext.shape[1] - (CONV_W - 1)
    y = u_ext[:, :T] * w[0]
    for k in range(1, CONV_W):
        y = y + u_ext[:, k:k + T] * w[k]
    return y


def mem_kv_from(mem, p):
    B, M, _ = mem.shape
    kv = jnp.einsum('bmd,de->bme', rmsnorm(mem, p['norm_mem']), p['w_mem_kv'])
    kv = kv.reshape(B, M, 2, MEM_HEADS, MEM_HEAD_DIM)
    return jnp.stack([rmsnorm(kv[:, :, 0], p['mem_k_norm']), kv[:, :, 1]], axis=2)


def mem_attend(mq, mem_kv):
    B, T = mq.shape[:2]
    s = jnp.einsum('bthd,bmhd->bthm', mq, mem_kv[:, :, 0]) * MEM_HEAD_DIM ** -0.5
    pr = jax.nn.softmax(s.astype(jnp.float32), axis=-1)
    o = jnp.einsum('bthm,bmhd->bthd', pr.astype(mem_kv.dtype), mem_kv[:, :, 1])
    return o.reshape(B, T, MEM_HEADS * MEM_HEAD_DIM)


def finish(x, o_nsa, z, o_mem, mg, p):
    br = jnp.stack([o_nsa, z, o_mem], axis=2)
    proj = jnp.einsum('btnc,ncd->btnd', br, p['w_branch'])
    h = x + jnp.einsum('btd,de->bte', jnp.sum(mg * proj, axis=2), p['w_out'])
    gu = jnp.einsum('btd,df->btf', rmsnorm(h, p['norm_ffn']), p['w_gate_up'])
    g, u = jnp.split(gu, 2, axis=-1)
    return h + jnp.einsum('btf,fd->btd', jax.nn.silu(g) * u, p['w_down'])


def setup_inputs(seed: int = 0) -> dict:
    key = jax.random.key(seed)
    ks = jax.random.split(key, 32)
    f32 = jnp.float32
    n_pages = PAST_LEN // PAGE_SIZE
    n_used = DEC_BATCH * n_pages
    n_phys = n_used + (n_used + 3) // 4
    w_buf = min(WINDOW, PAST_LEN)

    def nrm(k, shape, scale):
        return (scale * jax.random.normal(k, shape)).astype(f32)

    def gain(k, shape):
        return (1.0 + 0.02 * jax.random.normal(k, shape)).astype(f32)

    page_table = jax.random.permutation(ks[0], n_phys)[:n_used].reshape(DEC_BATCH, n_pages).astype(jnp.int32)
    return {
        'x_prompt': nrm(ks[1], (BATCH, SEQ, D_MODEL), 1.0),
        'x_sample': nrm(ks[2], (DEC_BATCH, DEC_SEQ, D_MODEL), 1.0),
        'cache_nsa_kv': nrm(ks[3], (DEPTH, n_phys, PAGE_SIZE, 4, N_KV, HEAD_DIM), 1.0),
        'cache_win_kv': nrm(ks[4], (DEPTH, DEC_BATCH, w_buf, 2, N_KV, HEAD_DIM), 1.0),
        'state_conv': nrm(ks[5], (DEPTH, DEC_BATCH, CONV_W - 1, CONV_CH), 1.0),
        'cache_mem_kv': nrm(ks[6], (DEPTH, DEC_BATCH, MEM_LEN, 2, MEM_HEADS, MEM_HEAD_DIM), 1.0),
        'page_table': page_table,
        'mem_prompt': nrm(ks[7], (BATCH, MEM_LEN, D_MODEL), 1.0),
        'norm_mix': gain(ks[8], (DEPTH, D_MODEL)),
        'w_in': nrm(ks[9], (DEPTH, D_MODEL, N_IN), D_MODEL ** -0.5),
        'q_norm': gain(ks[10], (DEPTH, HEAD_DIM)),
        'k_norm': gain(ks[11], (DEPTH, 3, HEAD_DIM)),
        'cmp_pe': nrm(ks[12], (DEPTH, 2, CMP_LEN, HEAD_DIM), 0.1),
        'cmp_w1': nrm(ks[13], (DEPTH, 2, CMP_LEN * HEAD_DIM, CMP_HIDDEN), (CMP_LEN * HEAD_DIM) ** -0.5),
        'cmp_w2': nrm(ks[14], (DEPTH, 2, CMP_HIDDEN, HEAD_DIM), CMP_HIDDEN ** -0.5),
        'conv_w': nrm(ks[15], (DEPTH, CONV_W, CONV_CH), CONV_W ** -0.5),
        'norm_mem': gain(ks[16], (DEPTH, D_MODEL)),
        'w_mem_kv': nrm(ks[17], (DEPTH, D_MODEL, 2 * MEM_HEADS * MEM_HEAD_DIM), D_MODEL ** -0.5),
        'mem_q_norm': gain(ks[18], (DEPTH, MEM_HEAD_DIM)),
        'mem_k_norm': gain(ks[19], (DEPTH, MEM_HEAD_DIM)),
        'w_branch': nrm(ks[20], (DEPTH, N_BRANCH, BRANCH_W, D_MODEL), BRANCH_W ** -0.5),
        'w_out': nrm(ks[21], (DEPTH, D_MODEL, D_MODEL), D_MODEL ** -0.5),
        'norm_ffn': gain(ks[22], (DEPTH, D_MODEL)),
        'w_gate_up': nrm(ks[23], (DEPTH, D_MODEL, 2 * D_FF), D_MODEL ** -0.5),
        'w_down': nrm(ks[24], (DEPTH, D_FF, D_MODEL), D_FF ** -0.5),
    }


def reference(x_prompt, x_sample, cache_nsa_kv, cache_win_kv, state_conv, cache_mem_kv, page_table, mem_prompt,
              norm_mix, w_in, q_norm, k_norm, cmp_pe, cmp_w1, cmp_w2, conv_w, norm_mem, w_mem_kv,
              mem_q_norm, mem_k_norm, w_branch, w_out, norm_ffn, w_gate_up, w_down):
    xp, xs = x_prompt, x_sample
    pos_p = jnp.arange(xp.shape[1])
    pos_s = PAST_LEN + jnp.arange(xs.shape[1])
    w_prompt = min(WINDOW, xp.shape[1])
    rows_p, rows_s, win_p, win_s, conv_p, conv_s, mem_p = [], [], [], [], [], [], []
    for l in range(DEPTH):
        p = dict(norm_mix=norm_mix[l], w_in=w_in[l], q_norm=q_norm[l], k_norm=k_norm[l], cmp_pe=cmp_pe[l],
                 cmp_w1=cmp_w1[l], cmp_w2=cmp_w2[l], norm_mem=norm_mem[l], w_mem_kv=w_mem_kv[l],
                 mem_q_norm=mem_q_norm[l], mem_k_norm=mem_k_norm[l], w_branch=w_branch[l], w_out=w_out[l],
                 norm_ffn=norm_ffn[l], w_gate_up=w_gate_up[l], w_down=w_down[l])
        t = prep(xp, pos_p, p)
        o_nsa = nsa_prompt(t, p)
        u_ext = jnp.pad(t['u'], ((0, 0), (CONV_W - 1, 0), (0, 0)))
        z = t['cb'] * dwconv(u_ext, conv_w[l])
        mkv = mem_kv_from(mem_prompt, p)
        o_mem = mem_attend(t['mq'], mkv)
        xp = finish(xp, o_nsa, z, o_mem, t['mg'], p)
        rows_p.append(t['rows'])
        win_p.append(t['win'][:, -w_prompt:])
        conv_p.append(u_ext[:, -(CONV_W - 1):])
        mem_p.append(mkv)
        t = prep(xs, pos_s, p)
        o_nsa, new_win = nsa_sample(t, cache_nsa_kv, l, cache_win_kv[l], page_table, p)
        u_ext = jnp.concatenate([state_conv[l], t['u']], axis=1)
        z = t['cb'] * dwconv(u_ext, conv_w[l])
        o_mem = mem_attend(t['mq'], cache_mem_kv[l])
        xs = finish(xs, o_nsa, z, o_mem, t['mg'], p)
        rows_s.append(t['rows'])
        win_s.append(new_win)
        conv_s.append(u_ext[:, -(CONV_W - 1):])
    return (xp, xs, jnp.stack(rows_p), jnp.stack(rows_s), jnp.stack(win_p), jnp.stack(win_s),
            jnp.stack(conv_p), jnp.stack(conv_s), jnp.stack(mem_p))
```

```cpp
#include <hip/hip_runtime.h>
#include <cstdio>
#include <cstdint>
#include <cmath>

#define LAS __attribute__((address_space(3)))
#define GAS __attribute__((address_space(1)))
#define DI __device__ __forceinline__

typedef unsigned short bf16_t;
typedef short bf16x8 __attribute__((ext_vector_type(8)));
typedef short s16x4 __attribute__((ext_vector_type(4)));
typedef float f32x4 __attribute__((ext_vector_type(4)));
typedef float f32x2 __attribute__((ext_vector_type(2)));
typedef float f32x16 __attribute__((ext_vector_type(16)));
typedef unsigned u32x4 __attribute__((ext_vector_type(4)));
typedef unsigned u32x2 __attribute__((ext_vector_type(2)));

constexpr int D_MODEL = 1024, BATCH = 4, SEQ = 4096, DEPTH = 2, DEC_B = 32, PAST = 8192, PAGE = 128;
constexpr int HD = 64, BW = 512, NH = 8, NKV = 2, GRP = 4;
constexpr int NPAGES = PAST / PAGE;
constexpr int NPHYS = 2560;
constexpr int MP = BATCH * SEQ;
constexpr int MS = DEC_B;
constexpr int MR = MP + 256;
constexpr int D_FF = 2816;
constexpr int N_IN = 6424;
constexpr int LDH = 6656;
constexpr int HQ = 0, HKV = 512, HCX = 1280, HCB = 1792, HCC = 2304, HMQ = 2816, HMG = 3328, HNG = 6400;
constexpr int SIG_TILE = 13;
constexpr float EPS = 1e-6f;
constexpr float LOG2E = 1.4426950408889634f;
constexpr float C2 = 0.125f * LOG2E;
constexpr float C2M = 0.08838834764831845f * LOG2E;

constexpr size_t O_Y = 0, O_YS = 16777216, O_ROWS = 16809984, O_ROWSS = 33587200, O_WIN = 33619968, O_WINS = 34668544,
                 O_CONV = 43057152, O_CONVS = 43065344, O_MKV = 43130880, O_TOTAL = 45228032;

constexpr size_t al4k(size_t x) { return (x + 4095) & ~(size_t)4095; }
constexpr size_t WS_CTL = 0, CTL_BYTES = 1u << 20;
constexpr size_t WS_SSQ = WS_CTL + 524288;
constexpr size_t SSQ_STRIDE = (size_t)(16384 + 256);
constexpr size_t WS_QUEUE = WS_CTL + 409600;
constexpr size_t WL_WIN = 0;
constexpr size_t WL_WBR = WL_WIN + al4k((size_t)LDH * 1024 * 2);
constexpr size_t WL_WOUT = WL_WBR + al4k((size_t)1024 * 1536 * 2);
constexpr size_t WL_WGU = WL_WOUT + al4k((size_t)1024 * 1024 * 2);
constexpr size_t WL_WDN = WL_WGU + al4k((size_t)5632 * 1024 * 2);
constexpr size_t WL_WMEM = WL_WDN + al4k((size_t)1024 * 2816 * 2);
constexpr size_t WL_W1C = WL_WMEM + al4k((size_t)1024 * 1024 * 2);
constexpr size_t WL_W2T = WL_W1C + al4k((size_t)2 * 256 * 1024 * 2);
constexpr size_t WL_CBP = WL_W2T + al4k((size_t)2 * 64 * 128 * 2);
constexpr size_t WL_CBF = WL_CBP + al4k((size_t)2 * 8 * 128 * 4);
constexpr size_t WL_SIZE = WL_CBF + al4k((size_t)2 * 128 * 4);
constexpr size_t WS_W = WS_CTL + CTL_BYTES;
constexpr size_t WS_XB = WS_W + 2 * WL_SIZE;
constexpr size_t WS_RINV = WS_XB + al4k((size_t)MR * 1024 * 2);
constexpr size_t WS_H = WS_RINV + al4k((size_t)MR * 4);
constexpr size_t WS_QC = WS_H + al4k((size_t)MR * LDH * 2);
constexpr size_t WS_QR = WS_QC + al4k((size_t)MR * 512 * 2);
constexpr size_t WS_KS = WS_QR + al4k((size_t)MR * 512 * 2);
constexpr size_t WS_VST = WS_KS + al4k((size_t)MP * 128 * 2);
constexpr size_t WS_KW = WS_VST + al4k((size_t)MP * 128 * 2);
constexpr size_t WS_VWT = WS_KW + al4k((size_t)MP * 128 * 2);
constexpr size_t WS_KC = WS_VWT + al4k((size_t)MP * 128 * 2);
constexpr size_t WS_VCT = WS_KC + al4k((size_t)8 * 256 * 64 * 2);
constexpr size_t WS_UP = WS_VCT + al4k((size_t)8 * 256 * 64 * 2);
constexpr size_t WS_OC = WS_UP + al4k((size_t)2 * 2048 * 256 * 2);
constexpr size_t WS_SEL = WS_OC + al4k((size_t)MR * 512 * 2);
constexpr size_t WS_BR = WS_SEL + al4k((size_t)MP * 2 * 8);
constexpr size_t WS_MQ = WS_BR + al4k((size_t)MR * 1536 * 2);
constexpr size_t WS_MG = WS_MQ + al4k((size_t)MR * 512 * 2);
constexpr size_t WS_HRES = WS_MG + al4k((size_t)MR * 1024 * 2);
constexpr size_t WS_HB = WS_HRES + al4k((size_t)MR * 1024 * 4);
constexpr size_t WS_RINV2 = WS_HB + al4k((size_t)MR * 1024 * 2);
constexpr size_t WS_ACT = WS_RINV2 + al4k((size_t)MR * 4);
constexpr size_t WS_XNEXT = WS_ACT + al4k((size_t)MR * D_FF * 2);
constexpr size_t WS_AC = WS_XNEXT + al4k((size_t)MR * 1024 * 4);
constexpr size_t WS_US = WS_AC + al4k((size_t)4 * 32768 * 1024 * 2);
constexpr size_t WS_KCS = WS_US + al4k((size_t)4 * 32768 * 256 * 2);
constexpr size_t WS_VCS = WS_KCS + al4k((size_t)2 * 32 * 2 * 512 * 64 * 4);
constexpr size_t WS_MEMB = WS_VCS + al4k((size_t)2 * 32 * 2 * 512 * 64 * 4);
constexpr size_t WS_RINVM = WS_MEMB + al4k((size_t)1024 * 1024 * 2);
constexpr size_t WS_MKVRAW = WS_RINVM + al4k((size_t)1024 * 4);
constexpr size_t WS_MK = WS_MKVRAW + al4k((size_t)2 * 1024 * 1024 * 4);
constexpr size_t WS_MVT = WS_MK + al4k((size_t)2 * 16 * 256 * 128 * 2);
constexpr size_t WS_SOUT = WS_MVT + al4k((size_t)2 * 16 * 256 * 128 * 2);
constexpr size_t WS_END = WS_SOUT + al4k((size_t)32 * 1536 * 4);

constexpr int LDS_MAIN = 131072;
constexpr int LDS_MISC = LDS_MAIN;
constexpr int LDS_GT = LDS_MAIN + 256;
constexpr int LDS_XS = LDS_MAIN + 2048;
constexpr int LDS_BYTES = 147456;

DI unsigned f2bf(float f) { unsigned u = __builtin_bit_cast(unsigned, f); return (u + 0x7fffu + ((u >> 16) & 1u)) >> 16; }
typedef __bf16 bf16x2_t __attribute__((ext_vector_type(2)));
DI unsigned pk2(float lo, float hi) { const f32x2 v = {lo, hi}; return __builtin_bit_cast(unsigned, __builtin_convertvector(v, bf16x2_t)); }
DI float bflo(unsigned w) { return __builtin_bit_cast(float, w << 16); }
DI float bfhi(unsigned w) { return __builtin_bit_cast(float, w & 0xffff0000u); }
DI float bf2f(bf16_t v) { return __builtin_bit_cast(float, (unsigned)v << 16); }
DI float fexp2(float x) { return __builtin_amdgcn_exp2f(x); }
DI float frcp(float x) { return __builtin_amdgcn_rcpf(x); }
DI float sigmoidf_(float v) { return frcp(1.0f + fexp2(-v * LOG2E)); }
DI float wave_sum(float v) {
#pragma unroll
    for (int o = 1; o < 64; o <<= 1) v += __shfl_xor(v, o);
    return v;
}
DI void unpack8(u32x4 w, float (&f)[8]) {
    f[0] = bflo(w.x); f[1] = bfhi(w.x); f[2] = bflo(w.y); f[3] = bfhi(w.y); f[4] = bflo(w.z); f[5] = bfhi(w.z); f[6] = bflo(w.w); f[7] = bfhi(w.w);
}
DI u32x4 pack8(const float (&f)[8]) { u32x4 w; w.x = pk2(f[0], f[1]); w.y = pk2(f[2], f[3]); w.z = pk2(f[4], f[5]); w.w = pk2(f[6], f[7]); return w; }
#define LDS_WAIT() asm volatile("s_waitcnt lgkmcnt(0)" ::: "memory")
#define VM_WAIT() asm volatile("s_waitcnt vmcnt(0)" ::: "memory")
#define MFMA32(a, b, c) __builtin_amdgcn_mfma_f32_32x32x16_bf16((a), (b), (c), 0, 0, 0)
#define MFMA16(a, b, c) __builtin_amdgcn_mfma_f32_16x16x32_bf16((a), (b), (c), 0, 0, 0)
DI int ltid() { int t = threadIdx.x; asm volatile("" : "+v"(t)); return t; }
DI int crow(int r, int hi) { return (r & 3) + 8 * (r >> 2) + 4 * hi; }

struct Params {
    const float* x_prompt; const float* x_sample; const float* cache_nsa; const float* cache_win; const float* state_conv; const float* cache_mem;
    const int* page_table; const float* mem_prompt; const float* norm_mix; const float* w_in; const float* q_norm; const float* k_norm;
    const float* cmp_pe; const float* cmp_w1; const float* cmp_w2; const float* conv_w; const float* norm_mem; const float* w_mem_kv;
    const float* mem_q_norm; const float* mem_k_norm; const float* w_branch; const float* w_out; const float* norm_ffn; const float* w_gate_up; const float* w_down;
    float* out; unsigned char* ws;
    int ph_lo, ph_hi, li, pad;
};
namespace pg8 {
constexpr int BM = 256, BK = 64, HALF = 128, HTB = HALF * BK * 2  , STAGE_BYTES = 8 * HTB, NXCD = 8, WGM = 2;

__host__ __device__ __forceinline__ int lds_byte(int r, int c) { const int st = (r >> 4) * 2 + (c >> 5), rr = r & 15, cc = c & 31, ob = rr * 64 + cc * 2; return st * 1024 + (ob ^ (((ob >> 9) & 1) << 5)); }
__host__ __device__ __forceinline__ void stage_rc(int b, int& R, int& C) { const int st = b / 1024, sb = b % 1024, swz = sb ^ (((sb >> 9) & 1) << 5); R = (st >> 1) * 16 + swz / 64; C = (st & 1) * 32 + (swz % 64) / 2; }
__host__ __device__ __forceinline__ int perm32(int rho) { const int n = rho >> 4, i = rho & 15; return 8 * (i >> 2) + 4 * n + (i & 3); }

struct Unit { int pm, pn, kb, grp; size_t aoff, boff; };
struct Gemm { const bf16_t* A; const bf16_t* Bt; int lda, ldb, K; };

DI bool static_tile(int i, int G, int c, int nM, int nN, int& pm, int& pn) {
    const int nwg = nM * nN; const long L = (long)i * G + c; if (L >= nwg) return false;
    int wgid = (int)L; { const int q = nwg / NXCD, r = nwg % NXCD, xcd = wgid % NXCD, off = wgid / NXCD; wgid = (xcd < r ? xcd * (q + 1) : r * (q + 1) + (xcd - r) * q) + off; }
    const int nig = WGM * nN, gid = wgid / nig, fm = gid * WGM, gsz = (nM - fm) < WGM ? (nM - fm) : WGM;
    pm = fm + ((wgid % nig) % gsz); pn = (wgid % nig) / gsz; return true;
}
struct SchedMN {
    int nM, nN, G, c; size_t ta, tb;
    DI bool next(int i, Unit& u) const { if (!static_tile(i, G, c, nM, nN, u.pm, u.pn)) return false; u.kb = 0; u.grp = 0; u.aoff = (size_t)u.pm * ta; u.boff = (size_t)u.pn * tb; return true; }
};
struct SchedInprojBal {
    int c; size_t ta, tb;
    DI static bool fusedcol(int pn) { return pn <= 1 || pn == 3 || pn == 4 || pn == 11 || pn == 12; }
    DI bool next(int i, Unit& u) const {
        const int cl = c & 127; const bool heavy = c < 128; int pmA, pnA, pmB, pnB;
        if (!static_tile(i, 256, cl, 64, 26, pmA, pnA)) return false;
        int pm = pmA, pn = pnA;
        if (static_tile(i, 256, cl + 128, 64, 26, pmB, pnB)) { const bool swap = fusedcol(pnA) && !fusedcol(pnB); if (heavy == swap) { pm = pmB; pn = pnB; } }
        else if (!heavy) return false;
        u.pm = pm; u.pn = pn; u.kb = 0; u.grp = 0; u.aoff = (size_t)pm * ta; u.boff = (size_t)pn * tb; return true; }
};
struct SchedBranch {
    int nM, nN, G, c; size_t ta, tb;
    DI bool next(int i, Unit& u) const { if (!static_tile(i / 3, G, c, nM, nN, u.pm, u.pn)) return false; u.kb = i % 3; u.grp = 0;
        u.aoff = (size_t)u.pm * ta + (size_t)u.kb * 1024; u.boff = (size_t)u.pn * tb + (size_t)u.kb * 1024; return true; }
};
struct SchedGroups {
    int nM, nN, ngrp, G, c; size_t ta, tb, ga, gb;
    DI bool next(int i, Unit& u) const { const long L = (long)i * G + c; const int per = nM * nN; if (L >= (long)per * ngrp) return false;
        const int gi = (int)(L / per), r = (int)(L % per); u.grp = gi; u.pm = r / nN; u.pn = r % nN; u.kb = 0;
        u.aoff = (size_t)gi * ga + (size_t)u.pm * ta; u.boff = (size_t)gi * gb + (size_t)u.pn * tb; return true; }
};

template <class Epi, class Sched>
DI void gemm_phase(LAS unsigned char* lds, const Gemm g, const Sched& S, const Epi& E) {
    const int tid = ltid(), wid = __builtin_amdgcn_readfirstlane(tid >> 6), lane = tid & 63, wr = wid >> 2, wc = wid & 3, fr = lane & 15, fq = lane >> 4;
    const int nt = g.K / BK;
    unsigned voffA[2], voffB[2];
#pragma unroll
    for (int i = 0; i < 2; ++i) { int R, C; stage_rc(tid * 16 + i * 8192, R, C); const int Rb = Epi::PERM ? ((R & ~31) + perm32(R & 31)) : R;
        voffA[i] = (unsigned)(R * g.lda + C) * 2u; voffB[i] = (unsigned)(Rb * g.ldb + C) * 2u; }
    const size_t kstep = (size_t)(BK * 2);
    const size_t hstepA = (size_t)HALF * g.lda * 2, hstepB = (size_t)HALF * g.ldb * 2;
    const unsigned ldsw = (unsigned)wid * 1024u;
    const int aoff = lds_byte(wr * 64 + fr, fq * 8), boff = lds_byte(wc * 32 + fr, fq * 8);
#define PG8_SA(b, h) (((b) * 2 + (h)) * HTB)
#define PG8_SB(b, h) ((4 + (b) * 2 + (h)) * HTB)
#define PG8_STAGE(bufoff, gbase, voff) do { _Pragma("unroll") for (int _i = 0; _i < 2; ++_i) \
        __builtin_amdgcn_global_load_lds((const unsigned*)((const char*)(gbase) + (voff)[_i]), (LAS unsigned*)(lds + (bufoff) + ldsw + _i * 8192), 16, 0, 0); } while (0)
#define PG8_LDA(dst, b, h) do { _Pragma("unroll") for (int m = 0; m < 4; ++m) _Pragma("unroll") for (int k = 0; k < 2; ++k) dst[m][k] = *(const LAS bf16x8*)(lds + PG8_SA(b, h) + aoff + m * 2048 + k * 1024); } while (0)
#define PG8_LDB(dst, b, h) do { _Pragma("unroll") for (int n = 0; n < 2; ++n) _Pragma("unroll") for (int k = 0; k < 2; ++k) dst[n][k] = *(const LAS bf16x8*)(lds + PG8_SB(b, h) + boff + n * 2048 + k * 1024); } while (0)
#define PG8_MMA(ai, bj, At, Bt) do { __builtin_amdgcn_s_setprio(1); _Pragma("unroll") for (int m = 0; m < 4; ++m) _Pragma("unroll") for (int n = 0; n < 2; ++n) _Pragma("unroll") for (int k = 0; k < 2; ++k) \
        acc[ai][bj][m][n] = __builtin_amdgcn_mfma_f32_16x16x32_bf16(Bt[n][k], At[m][k], acc[ai][bj][m][n], 0, 0, 0); __builtin_amdgcn_s_setprio(0); } while (0)
#define PG8_WAIT_V(n) asm volatile("s_waitcnt vmcnt(" #n ")" ::: "memory")
#define PG8_WAIT_L(n) asm volatile("s_waitcnt lgkmcnt(" #n ")" ::: "memory")
#define PG8_BAR __builtin_amdgcn_s_barrier()
#define PG8_SCHED __builtin_amdgcn_sched_barrier(0)
    Unit cur, nxt; int ui = 0;
    if (!S.next(0, cur)) return;
    f32x4 acc[2][2][4][2];
#pragma unroll
    for (int a = 0; a < 2; ++a)
#pragma unroll
        for (int b = 0; b < 2; ++b)
#pragma unroll
            for (int m = 0; m < 4; ++m)
#pragma unroll
                for (int n = 0; n < 2; ++n) acc[a][b][m][n] = (f32x4){0.f, 0.f, 0.f, 0.f};
    bf16x8 At[4][2], B0[2][2], B1[2][2];
    const char* cA = (const char*)g.A + cur.aoff; const char* cB = (const char*)g.Bt + cur.boff;
    PG8_STAGE(PG8_SB(0, 0), cB, voffB); PG8_STAGE(PG8_SB(0, 1), cB + hstepB, voffB); PG8_STAGE(PG8_SA(0, 0), cA, voffA); PG8_STAGE(PG8_SA(0, 1), cA + hstepA, voffA);
    if (wr == 1) PG8_BAR;
    PG8_WAIT_V(2); PG8_BAR;
    PG8_STAGE(PG8_SB(1, 0), cB + kstep, voffB); PG8_STAGE(PG8_SA(1, 0), cA + kstep, voffA); PG8_STAGE(PG8_SB(1, 1), cB + hstepB + kstep, voffB);
    PG8_WAIT_V(6); PG8_BAR;
    for (;;) {
        const bool has_next = S.next(ui + 1, nxt);
        const char* nA = has_next ? (const char*)g.A + nxt.aoff : cA; const char* nB = has_next ? (const char*)g.Bt + nxt.boff : cB;
        for (int t = 0; t < nt; t += 2) {
            const bool last = (t == nt - 2);
            const char* a1 = cA + (size_t)(t + 1) * kstep;
            const char* a2 = last ? nA : cA + (size_t)(t + 2) * kstep; const char* b2 = last ? nB : cB + (size_t)(t + 2) * kstep;
            const char* a3 = a2 + kstep; const char* b3 = b2 + kstep;
            PG8_LDB(B0, 0, 0); PG8_LDB(B1, 0, 1); PG8_SCHED; PG8_LDA(At, 0, 0); PG8_STAGE(PG8_SA(1, 1), a1 + hstepA, voffA);
            PG8_WAIT_V(8); PG8_WAIT_L(0); PG8_BAR; PG8_MMA(0, 0, At, B0); PG8_MMA(0, 1, At, B1); PG8_BAR; PG8_SCHED;
            PG8_LDA(At, 0, 1); PG8_STAGE(PG8_SB(0, 0), b2, voffB); PG8_STAGE(PG8_SB(0, 1), b2 + hstepB, voffB); PG8_STAGE(PG8_SA(0, 0), a2, voffA);
            PG8_WAIT_V(8); PG8_WAIT_L(0); PG8_BAR; PG8_MMA(1, 0, At, B0); PG8_MMA(1, 1, At, B1); PG8_BAR; PG8_SCHED;
            PG8_LDB(B0, 1, 0); PG8_LDB(B1, 1, 1); PG8_SCHED; PG8_LDA(At, 1, 0); PG8_STAGE(PG8_SA(0, 1), a2 + hstepA, voffA);
            PG8_WAIT_V(8); PG8_WAIT_L(0); PG8_BAR; PG8_MMA(0, 0, At, B0); PG8_MMA(0, 1, At, B1); PG8_BAR; PG8_SCHED;
            PG8_LDA(At, 1, 1); PG8_STAGE(PG8_SB(1, 0), b3, voffB); PG8_STAGE(PG8_SB(1, 1), b3 + hstepB, voffB); PG8_STAGE(PG8_SA(1, 0), a3, voffA);
            PG8_WAIT_V(8); PG8_WAIT_L(0); PG8_BAR; PG8_MMA(1, 0, At, B0); PG8_MMA(1, 1, At, B1); PG8_BAR; PG8_SCHED;
        }
        if (wr == 0) PG8_BAR;
        E(acc, cur, wr, wc, fr, fq);
        if (!has_next) break;
        if (!(Epi::CARRY && cur.kb < 2)) {
#pragma unroll
        for (int a = 0; a < 2; ++a)
#pragma unroll
            for (int b = 0; b < 2; ++b)
#pragma unroll
                for (int m = 0; m < 4; ++m)
#pragma unroll
                    for (int n = 0; n < 2; ++n) acc[a][b][m][n] = (f32x4){0.f, 0.f, 0.f, 0.f};
        }
        cur = nxt; cA = nA; cB = nB; ++ui;
        if (wr == 1) PG8_BAR;
    }
    PG8_WAIT_V(0);
    PG8_BAR;
#undef PG8_SA
#undef PG8_SB
#undef PG8_STAGE
#undef PG8_LDA
#undef PG8_LDB
#undef PG8_MMA
#undef PG8_WAIT_V
#undef PG8_WAIT_L
#undef PG8_BAR
#undef PG8_SCHED
}
}
#define XB_TMO      128
#define XB_XCNT(j)  (256  + 64 * (j))
#define XB_XSUB(j)  (1280 + 64 * (j))
#define XB_XGEN(j)  (2304 + 64 * (j))
#define XB_TOP      3328
#define XB_TOPGEN   3392
#define XCD_BAR_WORDS 3456
#define XB_SPIN_CAP (1u << 18)

__device__ __forceinline__ unsigned xb_ld(unsigned* p)              { return __hip_atomic_load(p, __ATOMIC_RELAXED, __HIP_MEMORY_SCOPE_AGENT); }
__device__ __forceinline__ unsigned xb_add(unsigned* p, unsigned v) { return __hip_atomic_fetch_add(p, v, __ATOMIC_RELAXED, __HIP_MEMORY_SCOPE_AGENT); }
__device__ __forceinline__ unsigned xb_xcc_id() { return (unsigned)__builtin_amdgcn_s_getreg((3 << 11) | 20) & 0xFu; }
#define XB_SPIN(cond, bar) do { unsigned _sp = 0; while (cond) { __builtin_amdgcn_s_sleep(1); \
    if ((++_sp & 255u) == 0u) { if (xb_ld(&(bar)[XB_TMO])) break; if (_sp > XB_SPIN_CAP) { atomicAdd(&(bar)[XB_TMO], 1u); break; } } } } while (0)

struct XcdBarrier {
    unsigned* bar; unsigned x;
    volatile LAS unsigned* st;
};

__device__ __forceinline__ XcdBarrier xcd_barrier_post(unsigned* bar, volatile LAS unsigned* st) {
    XcdBarrier b; b.bar = bar; b.x = xb_xcc_id(); b.st = st;
    if (threadIdx.x == 0) (void)xb_add(&bar[XB_XCNT(b.x)], 1u);
    return b;
}
__device__ __forceinline__ void xcd_barrier_complete(unsigned* bar, unsigned x, unsigned& nloc, unsigned& nx) {
    const unsigned G = gridDim.x * gridDim.y * gridDim.z;
    unsigned sum, cnt, mine, sp = 0u;
    for (;;) {
        sum = 0u; cnt = 0u; mine = 0u;
#pragma unroll
        for (unsigned j = 0; j < 16; ++j) { const unsigned c = xb_ld(&bar[XB_XCNT(j)]); sum += c; cnt += (c > 0u) ? 1u : 0u; mine = (j == x) ? c : mine; }
        if (sum == G) break;
        __builtin_amdgcn_s_sleep(1);
        if ((++sp & 255u) == 0u) { if (xb_ld(&bar[XB_TMO])) break; if (sp > XB_SPIN_CAP) { atomicAdd(&bar[XB_TMO], 1u); break; } }
    }
    nloc = mine > 0u ? mine : 1u; nx = cnt > 0u ? cnt : 1u;
}

__device__ __forceinline__ void xcd_barrier(const XcdBarrier& b) {
    asm volatile("s_waitcnt vmcnt(0)" ::: "memory");
    __syncthreads();
    if (threadIdx.x == 0) {
        unsigned* bar = b.bar;
        __builtin_amdgcn_s_waitcnt(0);
        unsigned nloc = b.st[0], nx = b.st[1];
        if (nloc == 0u) { xcd_barrier_complete(bar, b.x, nloc, nx); b.st[0] = nloc; b.st[1] = nx; }
        const unsigned old = xb_add(&bar[XB_XSUB(b.x)], 1u);
        const unsigned gen = old / nloc;
        if (old + 1u == (gen + 1u) * nloc) {
            __builtin_amdgcn_fence(__ATOMIC_RELEASE, "agent");
            asm volatile("s_waitcnt vmcnt(0)" ::: "memory");
            const unsigned og = xb_add(&bar[XB_TOP], 1u);
            const unsigned tg = og / nx;
            if (og + 1u == (tg + 1u) * nx) xb_add(&bar[XB_TOPGEN], 1u);
            else XB_SPIN(xb_ld(&bar[XB_TOPGEN]) == tg, bar);
            __builtin_amdgcn_fence(__ATOMIC_ACQUIRE, "agent");
            xb_add(&bar[XB_XGEN(b.x)], 1u);
            asm volatile("s_waitcnt vmcnt(0)" ::: "memory");
        } else {
            XB_SPIN(xb_ld(&bar[XB_XGEN(b.x)]) == gen, bar);
            __builtin_amdgcn_fence(__ATOMIC_ACQUIRE, "agent");
            asm volatile("s_waitcnt vmcnt(0)" ::: "memory");
        }
    }
    __syncthreads();
}

struct Frame {
    LAS unsigned char* lds;
    int tid, lane, wave;
    int gw, ngw;
    int cu, G;
};
DI Frame mk_frame(LAS unsigned char* lds) {
    Frame F; F.lds = lds; F.tid = ltid(); F.lane = F.tid & 63; F.wave = __builtin_amdgcn_readfirstlane(F.tid >> 6);
    F.cu = blockIdx.x; F.G = gridDim.x; F.gw = F.wave * F.G + F.cu; F.ngw = F.G * 8; return F;
}
DI unsigned char* wl(const Params& P, int l) { return P.ws + WS_W + (size_t)l * WL_SIZE; }

DI void transpose_item(const float* W, int ldw, int k0, int n0, int nvalid, const float* gain, bf16_t* dst, int row0, int ldk, int koff, LAS float* scr, int lane) {
    const int kr = lane >> 3, nq = lane & 7;
    f32x4 v[8];
#pragma unroll
    for (int i = 0; i < 8; ++i) { const int kk = 8 * i + kr; v[i] = (4 * nq < nvalid) ? *(const f32x4*)(W + (size_t)(k0 + kk) * ldw + n0 + 4 * nq) : (f32x4){0.f, 0.f, 0.f, 0.f}; }
#pragma unroll
    for (int i = 0; i < 8; ++i) { const int kk = 8 * i + kr; f32x4 x = v[i]; if (gain) x = x * gain[k0 + kk];
        LAS float* sp = scr + kk * 33 + 4 * nq; sp[0] = x.x; sp[1] = x.y; sp[2] = x.z; sp[3] = x.w; }
    LDS_WAIT();
    const int c = lane & 7;
#pragma unroll
    for (int j = 0; j < 4; ++j) { const int nn = (lane >> 3) + 8 * j; const LAS float* s = scr + (8 * c) * 33 + nn;
        u32x4 o; o.x = pk2(s[0 * 33], s[1 * 33]); o.y = pk2(s[2 * 33], s[3 * 33]); o.z = pk2(s[4 * 33], s[5 * 33]); o.w = pk2(s[6 * 33], s[7 * 33]);
        *(u32x4*)(dst + (size_t)(row0 + nn) * ldk + koff + k0 + 8 * c) = o; }
    LDS_WAIT();
}
constexpr int WI_IN = 16 * 208, WI_GU = 16 * 176, WI_DN = 44 * 32, WI_OUT = 16 * 32, WI_BR = 3 * 8 * 32, WI_MEM = 16 * 32, WI_W1 = 2 * 2 * 16 * 4, WI_W2 = 8;
constexpr int WI_LAYER = WI_IN + WI_GU + WI_DN + WI_OUT + WI_BR + WI_MEM + WI_W1 + WI_W2;
DI void weight_item(const Params& P, int l, int r, LAS float* scr, int lane) {
    unsigned char* W = wl(P, l);
    if (r < WI_IN) { const int kb = r / 208, db = r % 208; int src, nv = 32;
        if (db < 40) src = 32 * db; else if (db < 200) src = 32 * db + 24; else if (db == 200) { src = 1280; nv = 24; } else { src = 0; nv = 0; }
        transpose_item(P.w_in + (size_t)l * 1024 * N_IN, N_IN, 64 * kb, src, nv, P.norm_mix + l * 1024, (bf16_t*)(W + WL_WIN), 32 * db, 1024, 0, scr, lane); return; } r -= WI_IN;
    if (r < WI_GU) { const int kb = r / 176, db = r % 176, tile = db >> 3, w = db & 7; const int src = (w < 4) ? 128 * tile + 32 * w : D_FF + 128 * tile + 32 * (w - 4);
        transpose_item(P.w_gate_up + (size_t)l * 1024 * 5632, 5632, 64 * kb, src, 32, P.norm_ffn + l * 1024, (bf16_t*)(W + WL_WGU), 32 * db, 1024, 0, scr, lane); return; } r -= WI_GU;
    if (r < WI_DN) { const int kb = r / 32, db = r % 32;
        transpose_item(P.w_down + (size_t)l * D_FF * 1024, 1024, 64 * kb, 32 * db, 32, nullptr, (bf16_t*)(W + WL_WDN), 32 * db, D_FF, 0, scr, lane); return; } r -= WI_DN;
    if (r < WI_OUT) { const int kb = r / 32, db = r % 32;
        transpose_item(P.w_out + (size_t)l * 1024 * 1024, 1024, 64 * kb, 32 * db, 32, nullptr, (bf16_t*)(W + WL_WOUT), 32 * db, 1024, 0, scr, lane); return; } r -= WI_OUT;
    if (r < WI_BR) { const int br = r / 256, q = r % 256, kb = q / 32, db = q % 32;
        transpose_item(P.w_branch + ((size_t)l * 3 + br) * 512 * 1024, 1024, 64 * kb, 32 * db, 32, nullptr, (bf16_t*)(W + WL_WBR), 32 * db, 1536, 512 * br, scr, lane); return; } r -= WI_BR;
    if (r < WI_MEM) { const int kb = r / 32, db = r % 32;
        transpose_item(P.w_mem_kv + (size_t)l * 1024 * 1024, 1024, 64 * kb, 32 * db, 32, P.norm_mem + l * 1024, (bf16_t*)(W + WL_WMEM), 32 * db, 1024, 0, scr, lane); return; } r -= WI_MEM;
    if (r < WI_W1) { const int c = r / 128, q = r % 128, half = q / 64, q2 = q % 64, kb = q2 / 4, db = q2 % 4;
        transpose_item(P.cmp_w1 + ((size_t)(l * 2 + c) * 2048 + half * 1024) * 128, 128, 64 * kb, 32 * db, 32, nullptr, (bf16_t*)(W + WL_W1C) + (size_t)c * 256 * 1024, half * 128 + 32 * db, 1024, 0, scr, lane); return; } r -= WI_W1;
    { const int c = r / 4, q = r % 4, kb = q / 2, db = q % 2;
        transpose_item(P.cmp_w2 + (size_t)(l * 2 + c) * 128 * 64, 64, 64 * kb, 32 * db, 32, nullptr, (bf16_t*)(W + WL_W2T) + (size_t)c * 64 * 128, 32 * db, 128, 0, scr, lane); }
}
DI void row_to_bf16_rinv(const float* xrow, bf16_t* orow, float* rinv, int lane, bool raw) {
    const f32x4* xr = (const f32x4*)xrow + lane;
    f32x4 v[4]; float s = 0.f;
#pragma unroll
    for (int j = 0; j < 4; ++j) { v[j] = xr[64 * j]; s += (v[j].x * v[j].x + v[j].y * v[j].y) + (v[j].z * v[j].z + v[j].w * v[j].w); }
    s = wave_sum(s);
    u32x2* o8 = (u32x2*)orow + lane;
#pragma unroll
    for (int j = 0; j < 4; ++j) { u32x2 w; w.x = pk2(v[j].x, v[j].y); w.y = pk2(v[j].z, v[j].w); o8[64 * j] = w; }
    if (lane == 0) *rinv = raw ? s : 1.0f / sqrtf(s * (1.0f / 1024.0f) + EPS);
}
DI const float* xrow_in(const Params& P, int l, int m) {
    if (l == 0) return (m < MP) ? P.x_prompt + (size_t)m * 1024 : P.x_sample + (size_t)(m - MP) * 1024;
    return (const float*)(P.ws + WS_XNEXT) + (size_t)m * 1024;
}
DI void cache_item(const Params& P, int it, int lane) {
    const int l = it / 2048, r = it % 2048, b = r / 64, pg = r % 64;
    const int phys = P.page_table[b * 64 + pg];
    const float* src = P.cache_nsa + ((size_t)l * NPHYS + phys) * (128 * 512) + lane * 4;
    const int c = lane >> 5, g = (lane >> 4) & 1, d = 4 * (lane & 15);
    bf16_t* dstb = (bf16_t*)(P.ws + WS_AC) + (size_t)(l * 2 + c) * 32768 * 1024;
#pragma unroll 8
    for (int pos = 0; pos < 128; ++pos) {
        const f32x4 v = *(const f32x4*)(src + (size_t)pos * 512);
        const int jj = pos >> 4, s = pos & 15; const size_t row = (size_t)(b * 512 + 8 * pg + jj) * 2 + g;
        u32x2 w; w.x = pk2(v.x, v.y); w.y = pk2(v.z, v.w);
        *(u32x2*)(dstb + row * 1024 + s * 64 + d) = w;
    }
}
DI void cbias_item(const Params& P, int it, int lane) {
    const int l = it / 16, c = (it / 8) & 1, part = it & 7;
    const float* pe = P.cmp_pe + (size_t)(l * 2 + c) * 2048 + part * 256;
    const float* w1 = P.cmp_w1 + ((size_t)(l * 2 + c) * 2048 + part * 256) * 128;
    float a0 = 0.f, a1 = 0.f;
#pragma unroll 8
    for (int k = 0; k < 256; ++k) { const float p = pe[k]; a0 += p * w1[k * 128 + lane]; a1 += p * w1[k * 128 + 64 + lane]; }
    float* o = (float*)(wl(P, l) + WL_CBP) + (c * 8 + part) * 128;
    o[lane] = a0; o[64 + lane] = a1;
}
constexpr int WI_LATE = WI_LAYER - WI_MEM - WI_W1 - WI_W2;
constexpr int PA_CACHE = 0, PA_W = WI_LAYER + WI_MEM + WI_W1 + WI_W2, PA_X = MP + MS, PA_MEM = 1024, PA_CB = 32;
DI void phase_pa(const Params& P, const Frame& F) {
    LAS float* scr = (LAS float*)(F.lds + F.wave * 16384);
    constexpr int NIT = PA_CACHE + PA_W + PA_X + PA_MEM + PA_CB;
    for (int it = F.gw; it < NIT; it += F.ngw) {
        int r = it;
        if (r < PA_CACHE) { cache_item(P, r, F.lane); continue; } r -= PA_CACHE;
        if (r < PA_W) { if (r < WI_LAYER) weight_item(P, 0, r, scr, F.lane); else weight_item(P, 1, WI_LATE + (r - WI_LAYER), scr, F.lane); continue; } r -= PA_W;
        if (r < PA_X) { row_to_bf16_rinv(xrow_in(P, 0, r), (bf16_t*)(P.ws + WS_XB) + (size_t)r * 1024, (float*)(P.ws + WS_RINV) + r, F.lane, true); continue; } r -= PA_X;
        if (r < PA_MEM) { row_to_bf16_rinv(P.mem_prompt + (size_t)r * 1024, (bf16_t*)(P.ws + WS_MEMB) + (size_t)r * 1024, (float*)(P.ws + WS_RINVM) + r, F.lane, false); continue; } r -= PA_MEM;
        cbias_item(P, r, F.lane);
    }
}
typedef f32x4 (&AccRef)[2][2][4][2];
DI void load_rows8(const float* p, int row0, float (&r)[8]) {
#pragma unroll
    for (int q = 0; q < 8; ++q) r[q] = p[row0 + (q >> 2) * 128 + (q & 3) * 16];
    asm volatile("" : "+v"(r[0]), "+v"(r[1]), "+v"(r[2]), "+v"(r[3]), "+v"(r[4]), "+v"(r[5]), "+v"(r[6]), "+v"(r[7]));
}
DI float rinv_of(float ssq) { return __builtin_amdgcn_rsqf(ssq * (1.0f / 1024.0f) + EPS); }
struct EpiInproj {
    static constexpr bool PERM = true, CARRY = false;
    bf16_t* H; const float* ssq;
    DI void operator()(AccRef acc, const pg8::Unit& u, int wr, int wc, int fr, int fq) const {
        const int row0 = u.pm * 256 + wr * 64 + fr, col0 = u.pn * 256 + wc * 32 + 8 * fq; const bool sig = u.pn >= SIG_TILE;
#pragma unroll
        for (int ai = 0; ai < 2; ++ai)
#pragma unroll
            for (int m = 0; m < 4; ++m) { const int row = row0 + ai * 128 + m * 16; const float ri = rinv_of(ssq[row]); bf16_t* rp = H + (size_t)row * LDH + col0;
#pragma unroll
                for (int bj = 0; bj < 2; ++bj) { float v[8];
#pragma unroll
                    for (int n = 0; n < 2; ++n)
#pragma unroll
                        for (int e = 0; e < 4; ++e) { float x = acc[ai][bj][m][n][e] * ri; if (sig) x = sigmoidf_(x); v[n * 4 + e] = x; }
                    *(u32x4*)(rp + bj * 128) = pack8(v); } }
    }
};
DI void rope_cs(int pos, int i, float& c, float& s);
struct EpiInprojF {
    static constexpr bool PERM = true, CARRY = false;
    bf16_t* H; const float* ssq; LAS float* xs; const LAS float* gt; int l;
    bf16_t *QC, *QR, *KS, *KW, *VST, *VWT, *MQ; float* out;
    DI void operator()(AccRef acc, const pg8::Unit& u, int wr, int wc, int fr0, int fq) const {
        int fr = fr0; asm volatile("" : "+v"(fr));
        const int pn = u.pn, wid = wr * 4 + wc, row0 = u.pm * 256 + wr * 64 + fr, cw = wc * 32 + 8 * fq;
        LAS float* xsl = xs + (wid * 128 + fr) * 2;
        const LAS float* xsp = xs + ((wid ^ 1) * 128 + fr) * 2;
        const LAS float* xsq = xs + (wr * 4 * 128 + fr) * 2;
        const bool fusedk = (pn <= 1) || pn == 3 || pn == 4 || pn == 11 || pn == 12;
        if (!fusedk) {
            const bool sig = pn >= SIG_TILE; const int col0 = pn * 256 + cw;
            float rir[8];
            load_rows8(ssq, row0, rir);
#pragma unroll
            for (int q = 0; q < 8; ++q) rir[q] = rinv_of(rir[q]);
#pragma unroll
            for (int ai = 0; ai < 2; ++ai)
#pragma unroll
                for (int m = 0; m < 4; ++m) { const int row = row0 + ai * 128 + m * 16; const float ri = rir[ai * 4 + m]; bf16_t* rp = H + (size_t)row * LDH + col0;
#pragma unroll
                    for (int bj = 0; bj < 2; ++bj) { float v[8];
#pragma unroll
                        for (int n = 0; n < 2; ++n)
#pragma unroll
                            for (int e = 0; e < 4; ++e) { float x = acc[ai][bj][m][n][e] * ri; if (sig) { const float ee = 1.0f + fexp2(-x * LOG2E); x = (pn == 25) ? frcp(ee) : ee; } v[n * 4 + e] = x; }
                        *(u32x4*)(rp + bj * 128) = pack8(v);
                        if (pn == 2) { float* ro = out + O_ROWS + ((size_t)l * MP + row) * 512 + bj * 128 + cw;
                            *(f32x4*)ro = (f32x4){v[0], v[1], v[2], v[3]}; *(f32x4*)(ro + 4) = (f32x4){v[4], v[5], v[6], v[7]}; } } }
            return;
        }
        if (pn <= 1) fused<0>(acc, pn, wr, wc, fr, fq, row0, cw, xsl, xsp, xsq);
        else if (pn <= 4) fused<1>(acc, pn, wr, wc, fr, fq, row0, cw, xsl, xsp, xsq);
        else fused<2>(acc, pn, wr, wc, fr, fq, row0, cw, xsl, xsp, xsq);
    }
    template <int KIND>
    DI void fused(AccRef acc, int pn, int wr, int wc, int fr, int fq, int row0, int cw, LAS float* xsl, const LAS float* xsp, const LAS float* xsq) const {
        constexpr bool isq = KIND == 0, iskv = KIND == 1, ismq = KIND == 2;
        float rir[8];
        load_rows8(ssq, row0, rir);
#pragma unroll
        for (int q = 0; q < 8; ++q) rir[q] = rinv_of(rir[q]);
#pragma unroll
        for (int ai = 0; ai < 2; ++ai)
#pragma unroll
            for (int m = 0; m < 4; ++m) { const float ri = rir[ai * 4 + m];
#pragma unroll
                for (int bj = 0; bj < 2; ++bj) { float ss = 0.f;
#pragma unroll
                    for (int n = 0; n < 2; ++n)
#pragma unroll
                        for (int e = 0; e < 4; ++e) { const float x = acc[ai][bj][m][n][e]; ss += x * x; }
                    ss *= ri * ri;
                    ss += __shfl_xor(ss, 16); ss += __shfl_xor(ss, 32);
                    if (fq == 0) xsl[(ai * 4 + m) * 32 + bj] = ss; } }
        asm volatile("s_waitcnt lgkmcnt(0)" ::: "memory"); __builtin_amdgcn_s_barrier(); asm volatile("" ::: "memory");
        const int hd0 = (wc & 1) * 32 + 8 * fq;
#pragma unroll
        for (int ai = 0; ai < 2; ++ai)
#pragma unroll
            for (int m = 0; m < 4; ++m) { const int row = row0 + ai * 128 + m * 16, t = row & 4095, b = row >> 12; const float ri = rir[ai * 4 + m];
                float cs[8], sn[8];
                if (!ismq && (wc & 1) == 0) {
#pragma unroll
                    for (int j = 0; j < 8; ++j) rope_cs(t, j, cs[j], sn[j]); }
#pragma unroll
                for (int bj = 0; bj < 2; ++bj) {
                    const bool norm = isq || ismq || (iskv && bj == 0);
                    float hn = 1.f;
                    if (norm) { float tot; const int so = (ai * 4 + m) * 32 + bj;
                        if (ismq) tot = (xsq[so] + xsq[256 + so]) + (xsq[512 + so] + xsq[768 + so]);
                        else tot = xsl[so] + xsp[so];
                        hn = __builtin_amdgcn_rsqf(tot * (ismq ? (1.0f / 128.0f) : (1.0f / 64.0f)) + EPS); }
                    const LAS float* gp = gt + (isq ? 0 : (iskv ? (pn == 3 ? 64 : 128) : 192)) + (ismq ? cw : hd0);
                    const float sc = ri * hn * (isq ? C2 : (ismq ? C2M : 1.0f));
                    float y[8];
#pragma unroll
                    for (int n = 0; n < 2; ++n)
#pragma unroll
                        for (int e = 0; e < 4; ++e) { const int j = n * 4 + e; y[j] = acc[ai][bj][m][n][e] * (norm ? sc * gp[j] : ri); }
                    float yr[8];
#pragma unroll
                    for (int j = 0; j < 8; ++j) yr[j] = y[j];
                    if (norm && !ismq && (wc & 1) == 0) {
#pragma unroll
                        for (int j = 0; j < 8; ++j) { const float o = __shfl_xor(y[j], 16); if (fq < 2) yr[j] = y[j] * cs[j] + (fq == 0 ? -o : o) * sn[j]; } }
                    if (isq) { const int head = pn * 4 + bj * 2 + (wc >> 1);
                        *(u32x4*)(QC + (size_t)row * 512 + head * 64 + hd0) = pack8(y); *(u32x4*)(QR + (size_t)row * 512 + head * 64 + hd0) = pack8(yr); }
                    else if (ismq) { const int head = (pn - 11) * 2 + bj;
                        *(u32x4*)(MQ + (size_t)row * 512 + head * 128 + cw) = pack8(y); }
                    else { const int g = wc >> 1;
                        if (pn == 3) { float* ro = out + O_ROWS + ((size_t)l * MP + row) * 512 + (2 + bj) * 128 + g * 64 + hd0;
                            *(f32x4*)ro = (f32x4){yr[0], yr[1], yr[2], yr[3]}; *(f32x4*)(ro + 4) = (f32x4){yr[4], yr[5], yr[6], yr[7]}; }
                        else if (t >= SEQ - 512) { float* wo = out + O_WIN + ((((size_t)l * 4 + b) * 512 + (t - (SEQ - 512))) * 2 + bj) * 128 + g * 64 + hd0;
                            *(f32x4*)wo = (f32x4){yr[0], yr[1], yr[2], yr[3]}; *(f32x4*)(wo + 4) = (f32x4){yr[4], yr[5], yr[6], yr[7]}; }
                        if (bj == 0) { bf16_t* kp = (pn == 3 ? KS : KW) + ((size_t)row * 2 + g) * 64 + hd0; *(u32x4*)kp = pack8(yr); }
                        else { bf16_t* vp = (pn == 3 ? VST : VWT) + ((size_t)(b * 2 + g) * 64 + hd0) * 4096 + t;
#pragma unroll
                            for (int j = 0; j < 8; ++j) vp[(size_t)j * 4096] = (bf16_t)f2bf(yr[j]); } }
                } }
        asm volatile("s_waitcnt lgkmcnt(0)" ::: "memory"); __builtin_amdgcn_s_barrier(); asm volatile("" ::: "memory");
    }
};
struct EpiPlainBf16 {
    static constexpr bool PERM = true, CARRY = false;
    bf16_t* O; size_t gstride; int ldc;
    DI void operator()(AccRef acc, const pg8::Unit& u, int wr, int wc, int fr, int fq) const {
        const int row0 = u.pm * 256 + wr * 64 + fr, col0 = u.pn * 256 + wc * 32 + 8 * fq; bf16_t* base = O + (size_t)u.grp * gstride;
#pragma unroll
        for (int ai = 0; ai < 2; ++ai)
#pragma unroll
            for (int m = 0; m < 4; ++m) { bf16_t* rp = base + (size_t)(row0 + ai * 128 + m * 16) * ldc + col0;
#pragma unroll
                for (int bj = 0; bj < 2; ++bj) { float v[8];
#pragma unroll
                    for (int n = 0; n < 2; ++n)
#pragma unroll
                        for (int e = 0; e < 4; ++e) v[n * 4 + e] = acc[ai][bj][m][n][e];
                    *(u32x4*)(rp + bj * 128) = pack8(v); } }
    }
};
struct EpiScaleF32 {
    static constexpr bool PERM = false, CARRY = false;
    float* O; size_t gstride; int ldc; const float* rs;
    DI void operator()(AccRef acc, const pg8::Unit& u, int wr, int wc, int fr, int fq) const {
        const int row0 = u.pm * 256 + wr * 64 + fr, col0 = u.pn * 256 + wc * 32 + 4 * fq; float* base = O + (size_t)u.grp * gstride;
        float rir[8];
        load_rows8(rs, row0, rir);
#pragma unroll
        for (int ai = 0; ai < 2; ++ai)
#pragma unroll
            for (int m = 0; m < 4; ++m) { const int row = row0 + ai * 128 + m * 16; const float ri = rir[ai * 4 + m]; float* rp = base + (size_t)row * ldc + col0;
#pragma unroll
                for (int bj = 0; bj < 2; ++bj)
#pragma unroll
                    for (int n = 0; n < 2; ++n) *(f32x4*)(rp + bj * 128 + n * 16) = acc[ai][bj][m][n] * ri; }
    }
};
struct EpiBranch {
    static constexpr bool PERM = true, CARRY = true;
    bf16_t* MG; const bf16_t* H;
    DI void operator()(AccRef acc, const pg8::Unit& u, int wr, int wc, int fr, int fq) const {
        const int row0 = u.pm * 256 + wr * 64 + fr, col0 = u.pn * 256 + wc * 32 + 8 * fq;
#pragma unroll
        for (int ai = 0; ai < 2; ++ai) {
            u32x4 ga[4][2], gb[4][2];
#pragma unroll
            for (int m = 0; m < 4; ++m) { const bf16_t* gp = H + (size_t)(row0 + ai * 128 + m * 16) * LDH + HMG + u.kb * 1024 + col0;
#pragma unroll
                for (int bj = 0; bj < 2; ++bj) { ga[m][bj] = *(const u32x4*)(gp + bj * 128); gb[m][bj] = (u.kb < 2) ? *(const u32x4*)(gp + 1024 + bj * 128) : (u32x4){0u, 0u, 0u, 0u}; } }
#pragma unroll
            for (int m = 0; m < 4; ++m) { const int row = row0 + ai * 128 + m * 16;
#pragma unroll
                for (int bj = 0; bj < 2; ++bj) { float g0[8], g1[8]; unpack8(ga[m][bj], g0); unpack8(gb[m][bj], g1);
                    if (u.kb < 2) {
#pragma unroll
                        for (int n = 0; n < 2; ++n)
#pragma unroll
                            for (int e = 0; e < 4; ++e) { const int i = n * 4 + e; acc[ai][bj][m][n][e] *= g1[i] * frcp(g0[i]); }
                    } else { float v[8];
#pragma unroll
                        for (int n = 0; n < 2; ++n)
#pragma unroll
                            for (int e = 0; e < 4; ++e) { const int i = n * 4 + e; v[i] = acc[ai][bj][m][n][e] * frcp(g0[i]); }
                        *(u32x4*)(MG + (size_t)row * 1024 + col0 + bj * 128) = pack8(v); } } } }
    }
};
struct EpiResidual {
    static constexpr bool PERM = false, CARRY = false;
    const float* base; float* O; bf16_t* OB; float* ssq;
    DI void operator()(AccRef acc, const pg8::Unit& u, int wr, int wc, int fr, int fq) const {
        const int row0 = u.pm * 256 + wr * 64 + fr, col0 = u.pn * 256 + wc * 32 + 4 * fq;
#pragma unroll
        for (int ai = 0; ai < 2; ++ai) {
            f32x4 br[4][2][2];
#pragma unroll
            for (int m = 0; m < 4; ++m) { const float* bp = base + (size_t)(row0 + ai * 128 + m * 16) * 1024 + col0;
#pragma unroll
                for (int bj = 0; bj < 2; ++bj)
#pragma unroll
                    for (int n = 0; n < 2; ++n) br[m][bj][n] = *(const f32x4*)(bp + bj * 128 + n * 16); }
#pragma unroll
            for (int m = 0; m < 4; ++m) { const int row = row0 + ai * 128 + m * 16; float* rp = O + (size_t)row * 1024 + col0; float ss = 0.f;
#pragma unroll
                for (int bj = 0; bj < 2; ++bj)
#pragma unroll
                    for (int n = 0; n < 2; ++n) { const f32x4 v = br[m][bj][n] + acc[ai][bj][m][n]; *(f32x4*)(rp + bj * 128 + n * 16) = v;
                        if (OB) { u32x2 w; w.x = pk2(v.x, v.y); w.y = pk2(v.z, v.w); *(u32x2*)(OB + (size_t)row * 1024 + col0 + bj * 128 + n * 16) = w; ss += (v.x * v.x + v.y * v.y) + (v.z * v.z + v.w * v.w); } }
                if (OB) { ss += __shfl_xor(ss, 16); ss += __shfl_xor(ss, 32); if (fq == 0) atomicAdd(ssq + row, ss); } } }
    }
};
struct EpiGateUp {
    static constexpr bool PERM = true, CARRY = false;
    bf16_t* ACT; const float* ssq;
    DI void operator()(AccRef acc, const pg8::Unit& u, int wr, int wc, int fr, int fq) const {
        const int row0 = u.pm * 256 + wr * 64 + fr, f0 = u.pn * 128 + wc * 32 + 8 * fq;
        float rir[8];
        load_rows8(ssq, row0, rir);
#pragma unroll
        for (int q = 0; q < 8; ++q) rir[q] = rinv_of(rir[q]);
#pragma unroll
        for (int ai = 0; ai < 2; ++ai)
#pragma unroll
            for (int m = 0; m < 4; ++m) { const int row = row0 + ai * 128 + m * 16; const float ri = rir[ai * 4 + m]; float v[8];
#pragma unroll
                for (int n = 0; n < 2; ++n)
#pragma unroll
                    for (int e = 0; e < 4; ++e) { const float g = acc[ai][0][m][n][e] * ri, uu = acc[ai][1][m][n][e] * ri; v[n * 4 + e] = g * sigmoidf_(g) * uu; }
                *(u32x4*)(ACT + (size_t)row * D_FF + f0) = pack8(v); }
    }
};

template <int NSEG, class AP, class BP>
DI void small_gemm_tile(LAS unsigned char* lds, int K, const AP& ap, const BP& bp) {
    const int tid = ltid(), wid = __builtin_amdgcn_readfirstlane(tid >> 6), lane = tid & 63, r32 = lane & 31, hi = lane >> 5;
    const int kper = K / 8, k0 = wid * kper;
    LAS float* red = (LAS float*)lds; LAS float* fin = (LAS float*)(lds + NSEG * 32768);
    __syncthreads();
    f32x16 acc[NSEG];
#pragma unroll
    for (int seg = 0; seg < NSEG; ++seg) {
        acc[seg] = f32x16{};
        for (int kb = k0; kb < k0 + kper; kb += 64) {
            bf16x8 bfr[4], afr[4];
#pragma unroll
            for (int q = 0; q < 4; ++q) { const int k = kb + 16 * q; const bool ok = k < k0 + kper; const int kc = ok ? k : kb;
                bfr[q] = *(const bf16x8*)bp(seg, r32, kc + 8 * hi); afr[q] = *(const bf16x8*)ap(seg, r32, kc + 8 * hi); if (!ok) afr[q] = (bf16x8){0, 0, 0, 0, 0, 0, 0, 0}; }
#pragma unroll
            for (int q = 0; q < 4; ++q) acc[seg] = MFMA32(bfr[q], afr[q], acc[seg]);
        }
    }
#pragma unroll
    for (int seg = 0; seg < NSEG; ++seg)
#pragma unroll
        for (int r = 0; r < 16; ++r) red[(seg * 8 + wid) * 1024 + crow(r, hi) * 32 + r32] = acc[seg][r];
    __syncthreads();
    for (int e = tid; e < NSEG * 1024; e += 512) { const int seg = e >> 10, ee = e & 1023; float s = 0.f;
#pragma unroll
        for (int w = 0; w < 8; ++w) s += red[(seg * 8 + w) * 1024 + ee];
        fin[e] = s; }
    __syncthreads();
}

DI void ugemm_unit(const Params& P, int grp, int pmq, LAS unsigned char* lds) {
    using namespace pg8;
    const int tid = ltid(), wid = __builtin_amdgcn_readfirstlane(tid >> 6), lane = tid & 63, wr = wid >> 2, wc = wid & 3, fr = lane & 15, fq = lane >> 4;
    const int l = grp >> 1, c = grp & 1;
    const float* asrc[2];
    const bool tail = pmq >= 256; const int sb = pmq >> 3, st = pmq & 7, tt = pmq - 256;
#pragma unroll
    for (int i = 0; i < 2; ++i) { int R, C; stage_rc(tid * 16 + i * 8192, R, C); const int jl_ = R >> 1, b = tail ? 8 * tt + (jl_ >> 3) : sb, j = tail ? 504 + (jl_ & 7) : 63 * st + jl_, g = R & 1;
        asrc[i] = P.cache_nsa + (((size_t)l * NPHYS + P.page_table[b * 64 + (j >> 3)]) * 128 + (j & 7) * 16) * 512 + c * 128 + g * 64 + C; }
    unsigned voffB[2];
#pragma unroll
    for (int i = 0; i < 2; ++i) { int R, C; stage_rc(tid * 16 + i * 8192, R, C); const int Rb = (R & ~31) + perm32(R & 31); voffB[i] = (unsigned)(Rb * 1024 + C) * 2u; }
    const char* cB = (const char*)(wl(P, l) + WL_W1C) + (size_t)c * (256 * 1024 * 2);
    const unsigned ldsw = (unsigned)wid * 1024u;
    const int aoff = lds_byte(wr * 64 + fr, fq * 8), boff = lds_byte(wc * 32 + fr, fq * 8);
#define UG_SA(b) ((b) * HTB)
#define UG_SB(b, h) (32768 + ((b) * 2 + (h)) * HTB)
#define UG_STAGEB(buf, ks) do { _Pragma("unroll") for (int h_ = 0; h_ < 2; ++h_) _Pragma("unroll") for (int _i = 0; _i < 2; ++_i) \
        __builtin_amdgcn_global_load_lds((const unsigned*)(cB + (size_t)h_ * (128 * 1024 * 2) + (size_t)(ks) * 128 + voffB[_i]), (LAS unsigned*)(lds + UG_SB(buf, h_) + ldsw + _i * 8192), 16, 0, 0); } while (0)
    f32x4 ar0[2][2], ar1[2][2];
#define UG_LOADA(R, ks) do { _Pragma("unroll") for (int _i = 0; _i < 2; ++_i) { const float* p_ = asrc[_i] + (size_t)(ks) * 512; \
        asm volatile("global_load_dwordx4 %0, %1, off" : "=v"(R[_i][0]) : "v"(p_) : "memory"); asm volatile("global_load_dwordx4 %0, %1, off offset:16" : "=v"(R[_i][1]) : "v"(p_) : "memory"); } } while (0)
#define UG_WAITA(R, n) asm volatile("s_waitcnt vmcnt(" #n ")" : "+v"(R[0][0]), "+v"(R[0][1]), "+v"(R[1][0]), "+v"(R[1][1]) :: "memory")
#define UG_WRITEA(R, buf) do { _Pragma("unroll") for (int _i = 0; _i < 2; ++_i) { u32x4 w_; w_.x = pk2(R[_i][0].x, R[_i][0].y); w_.y = pk2(R[_i][0].z, R[_i][0].w); w_.z = pk2(R[_i][1].x, R[_i][1].y); w_.w = pk2(R[_i][1].z, R[_i][1].w); \
        *(LAS u32x4*)(lds + UG_SA(buf) + tid * 16 + _i * 8192) = w_; } } while (0)
    bf16x8 At[4][2], B0[2][2], B1[2][2];
#define UG_READ(cur) do { \
        _Pragma("unroll") for (int m = 0; m < 4; ++m) _Pragma("unroll") for (int k = 0; k < 2; ++k) At[m][k] = *(const LAS bf16x8*)(lds + UG_SA(cur) + aoff + m * 2048 + k * 1024); \
        _Pragma("unroll") for (int n = 0; n < 2; ++n) _Pragma("unroll") for (int k = 0; k < 2; ++k) { B0[n][k] = *(const LAS bf16x8*)(lds + UG_SB(cur, 0) + boff + n * 2048 + k * 1024); B1[n][k] = *(const LAS bf16x8*)(lds + UG_SB(cur, 1) + boff + n * 2048 + k * 1024); } \
        asm volatile("s_waitcnt lgkmcnt(0)" ::: "memory"); __builtin_amdgcn_sched_barrier(0); } while (0)
#define UG_MMA() do { _Pragma("unroll") for (int m = 0; m < 4; ++m) _Pragma("unroll") for (int n = 0; n < 2; ++n) _Pragma("unroll") for (int k = 0; k < 2; ++k) { acc[0][m][n] = MFMA16(B0[n][k], At[m][k], acc[0][m][n]); acc[1][m][n] = MFMA16(B1[n][k], At[m][k], acc[1][m][n]); } } while (0)
    f32x4 acc[2][4][2];
#pragma unroll
    for (int b = 0; b < 2; ++b)
#pragma unroll
        for (int m = 0; m < 4; ++m)
#pragma unroll
            for (int n = 0; n < 2; ++n) acc[b][m][n] = (f32x4){0.f, 0.f, 0.f, 0.f};
    __syncthreads();
    UG_STAGEB(0, 0); UG_LOADA(ar0, 0); UG_LOADA(ar1, 1);
    UG_WAITA(ar0, 4); UG_WRITEA(ar0, 0);
    asm volatile("s_waitcnt vmcnt(4) lgkmcnt(0)" ::: "memory"); __builtin_amdgcn_s_barrier();
#pragma unroll 1
    for (int ks = 0; ks < 16; ks += 2) {
        UG_READ(0); UG_STAGEB(1, ks + 1); UG_LOADA(ar0, ks + 2 < 16 ? ks + 2 : 15); __builtin_amdgcn_sched_barrier(0);
        UG_MMA();
        UG_WAITA(ar1, 8); UG_WRITEA(ar1, 1);
        asm volatile("s_waitcnt vmcnt(4) lgkmcnt(0)" ::: "memory"); __builtin_amdgcn_s_barrier();
        UG_READ(1); UG_STAGEB(0, ks + 2 < 16 ? ks + 2 : 15); UG_LOADA(ar1, ks + 3 < 16 ? ks + 3 : 15); __builtin_amdgcn_sched_barrier(0);
        UG_MMA();
        UG_WAITA(ar0, 8); UG_WRITEA(ar0, 0);
        asm volatile("s_waitcnt vmcnt(4) lgkmcnt(0)" ::: "memory"); __builtin_amdgcn_s_barrier();
    }
    UG_WAITA(ar1, 0);
    constexpr int PU = 528;
    LAS unsigned char* ut = lds; LAS float* cbl = (LAS float*)(lds + 128 * PU);
    __syncthreads();
#pragma unroll
    for (int m = 0; m < 4; ++m) { LAS unsigned char* rp = ut + (wr * 64 + m * 16 + fr) * PU + (wc * 32 + 8 * fq) * 2;
#pragma unroll
        for (int bj = 0; bj < 2; ++bj) { float v[8];
#pragma unroll
            for (int n = 0; n < 2; ++n)
#pragma unroll
                for (int e = 0; e < 4; ++e) v[n * 4 + e] = acc[bj][m][n][e];
            *(LAS u32x4*)(rp + bj * 256) = pack8(v); } }
    if (tid < 128) { const float* cp = (const float*)(wl(P, l) + WL_CBP) + c * 1024; float a = 0.f;
#pragma unroll
        for (int q = 0; q < 8; ++q) a += cp[q * 128 + tid];
        cbl[tid] = a; }
    { const int tr = lane & 15, q = lane >> 4, g = wid & 1, jl = 16 * (wid >> 1) + tr, i = tail ? 504 + (jl & 7) : 63 * st + jl, ob = tail ? 8 * tt + (jl >> 3) : sb; const bool valid = tail ? (jl & 7) < 7 : jl < 63;
      const bf16_t* W2T = (const bf16_t*)(wl(P, l) + WL_W2T) + (size_t)c * 64 * 128;
      u32x4 w2[4][4];
#pragma unroll
      for (int ct = 0; ct < 4; ++ct)
#pragma unroll
          for (int s2 = 0; s2 < 4; ++s2) w2[ct][s2] = *(const u32x4*)(W2T + (size_t)(16 * ct + tr) * 128 + 32 * s2 + 8 * q);
      __syncthreads();
      const int r0 = 2 * jl + g, r1 = (jl < 63) ? r0 + 2 : r0;
      bf16x8 bfr[4];
#pragma unroll
      for (int s2 = 0; s2 < 4; ++s2) { const int n0 = 32 * s2 + 8 * q; float a[8], bb[8], h[8];
          unpack8(*(const LAS u32x4*)(ut + r0 * PU + n0 * 2), a); unpack8(*(const LAS u32x4*)(ut + r1 * PU + (128 + n0) * 2), bb);
#pragma unroll
          for (int j2 = 0; j2 < 8; ++j2) { const float x = a[j2] + bb[j2] + cbl[n0 + j2]; h[j2] = x * sigmoidf_(x); }
          bfr[s2] = __builtin_bit_cast(bf16x8, pack8(h)); }
      f32x4 fa[4];
#pragma unroll
      for (int ct = 0; ct < 4; ++ct) { fa[ct] = (f32x4){0.f, 0.f, 0.f, 0.f};
#pragma unroll
          for (int s2 = 0; s2 < 4; ++s2) fa[ct] = MFMA16(__builtin_bit_cast(bf16x8, w2[ct][s2]), bfr[s2], fa[ct]); }
      if (c == 0) { float ss = 0.f; const float* knorm = P.k_norm + (l * 3 + 0) * 64;
#pragma unroll
          for (int ct = 0; ct < 4; ++ct) ss += (fa[ct].x * fa[ct].x + fa[ct].y * fa[ct].y) + (fa[ct].z * fa[ct].z + fa[ct].w * fa[ct].w);
          ss += __shfl_xor(ss, 16); ss += __shfl_xor(ss, 32);
          const float ri = 1.0f / sqrtf(ss * (1.0f / 64.0f) + EPS);
#pragma unroll
          for (int ct = 0; ct < 4; ++ct) { const f32x4 gn = *(const f32x4*)(knorm + 16 * ct + 4 * q); fa[ct] = fa[ct] * ri * gn; } }
      float* O = (float*)(P.ws + (c ? WS_VCS : WS_KCS)) + ((size_t)(l * 32 + ob) * 2 + g) * 512 * 64;
      if (valid) {
#pragma unroll
          for (int ct = 0; ct < 4; ++ct) *(f32x4*)(O + (size_t)i * 64 + 16 * ct + 4 * q) = fa[ct]; } }
#undef UG_SA
#undef UG_SB
#undef UG_STAGEB
#undef UG_LOADA
#undef UG_WRITEA
#undef UG_WAITA
#undef UG_READ
#undef UG_MMA
}
DI void rope_cs(int pos, int i, float& c, float& s) {
    constexpr float INV2PI[8] = {0.15915494309189535f, 0.03086376340470123f, 0.005985185712713705f, 0.001160663641240061f,
                                 0.00022507907903927653f, 4.364795279280289e-05f, 8.464330808241401e-06f, 1.6414262627950345e-06f};
    const float tf = __builtin_amdgcn_fractf((float)pos * INV2PI[i]);
    s = __builtin_amdgcn_sinf(tf); c = __builtin_amdgcn_cosf(tf);
}
DI void post_row(const Params& P, int l, int m, int lane) {
    const bool smp = m >= MP; const int b = smp ? (m - MP) : (m >> 12), t = smp ? 0 : (m & 4095), pos = smp ? PAST : t;
    const bf16_t* Hr = (const bf16_t*)(P.ws + WS_H) + (size_t)m * LDH;
    float cs[8], sn[8];
#pragma unroll
    for (int i = 0; i < 8; ++i) rope_cs(pos, i, cs[i], sn[i]);
    const int sub = lane & 7;
    {
        float v[8]; unpack8(*(const u32x4*)(Hr + HQ + 8 * lane), v);
        float ss = 0.f;
#pragma unroll
        for (int j = 0; j < 8; ++j) ss += v[j] * v[j];
        ss += __shfl_xor(ss, 1); ss += __shfl_xor(ss, 2); ss += __shfl_xor(ss, 4);
        const float ri = 1.0f / sqrtf(ss * (1.0f / 64.0f) + EPS);
        const float* gn = P.q_norm + l * 64 + 8 * sub;
        float y[8], yc[8], yr[8];
#pragma unroll
        for (int j = 0; j < 8; ++j) { y[j] = v[j] * ri * gn[j]; yc[j] = y[j] * C2; }
#pragma unroll
        for (int j = 0; j < 8; ++j) { const float o = __shfl_xor(y[j], 1);
            float r = y[j];
            if (sub == 0) r = y[j] * cs[j] - o * sn[j]; else if (sub == 1) r = y[j] * cs[j] + o * sn[j];
            yr[j] = r * C2; }
        *(u32x4*)((bf16_t*)(P.ws + WS_QC) + (size_t)m * 512 + 8 * lane) = pack8(yc);
        *(u32x4*)((bf16_t*)(P.ws + WS_QR) + (size_t)m * 512 + 8 * lane) = pack8(yr);
    }
    float* rows_out = smp ? P.out + O_ROWSS + ((size_t)l * 32 + b) * 512 : P.out + O_ROWS + (((size_t)l * 4 + b) * 4096 + t) * 512;
#pragma unroll
    for (int pass = 0; pass < 2; ++pass) {
        const int vi = pass * 8 + (lane >> 3); const bool act = vi < 12; const int vic = act ? vi : 0;
        const int br = vic >> 2, kvsel = (vic >> 1) & 1, g = vic & 1;
        float v[8]; unpack8(*(const u32x4*)(Hr + HKV + vic * 64 + 8 * sub), v);
        float ss = 0.f;
#pragma unroll
        for (int j = 0; j < 8; ++j) ss += v[j] * v[j];
        ss += __shfl_xor(ss, 1); ss += __shfl_xor(ss, 2); ss += __shfl_xor(ss, 4);
        const float ri = 1.0f / sqrtf(ss * (1.0f / 64.0f) + EPS);
        const bool isk = (kvsel == 0) && (br >= 1);
        const float* gn = P.k_norm + (l * 3 + (isk ? br : 1)) * 64 + 8 * sub;
        float y[8];
#pragma unroll
        for (int j = 0; j < 8; ++j) y[j] = isk ? v[j] * ri * gn[j] : v[j];
#pragma unroll
        for (int j = 0; j < 8; ++j) { const float o = __shfl_xor(y[j], 1);
            if (isk) { if (sub == 0) y[j] = y[j] * cs[j] - o * sn[j]; else if (sub == 1) y[j] = y[j] * cs[j] + o * sn[j]; } }
        if (act) {
            const int d0 = 8 * sub;
            if (br <= 1) {
                const int kind = br * 2 + kvsel; float* ro = rows_out + kind * 128 + g * 64 + d0;
                *(f32x4*)ro = (f32x4){y[0], y[1], y[2], y[3]}; *(f32x4*)(ro + 4) = (f32x4){y[4], y[5], y[6], y[7]};
            }
            if (br == 2) {
                float* wo = nullptr;
                if (smp) wo = P.out + O_WINS + ((((size_t)l * 32 + b) * 512 + 511) * 2 + kvsel) * 128 + g * 64 + d0;
                else if (t >= SEQ - 512) wo = P.out + O_WIN + ((((size_t)l * 4 + b) * 512 + (t - (SEQ - 512))) * 2 + kvsel) * 128 + g * 64 + d0;
                if (wo) { *(f32x4*)wo = (f32x4){y[0], y[1], y[2], y[3]}; *(f32x4*)(wo + 4) = (f32x4){y[4], y[5], y[6], y[7]}; }
            }
            if (!smp && br >= 1) {
                if (kvsel == 0) { bf16_t* kp = (bf16_t*)(P.ws + (br == 1 ? WS_KS : WS_KW)) + ((size_t)m * 2 + g) * 64 + d0; *(u32x4*)kp = pack8(y); }
                else { bf16_t* vp = (bf16_t*)(P.ws + (br == 1 ? WS_VST : WS_VWT)) + ((size_t)(b * 2 + g) * 64 + d0) * 4096 + t;
#pragma unroll
                    for (int j = 0; j < 8; ++j) vp[(size_t)j * 4096] = (bf16_t)f2bf(y[j]); }
            }
        }
    }
    {
        const int ch = 8 * lane; float cx[8], cb[8], cc[8], u0[8], u1[8], u2[8];
        unpack8(*(const u32x4*)(Hr + HCX + ch), cx); unpack8(*(const u32x4*)(Hr + HCB + ch), cb); unpack8(*(const u32x4*)(Hr + HCC + ch), cc);
#pragma unroll
        for (int j = 0; j < 8; ++j) u0[j] = cc[j] * cx[j];
        if (smp) {
            const float* st = P.state_conv + ((size_t)l * 32 + b) * 2 * 512 + ch;
#pragma unroll
            for (int j = 0; j < 8; ++j) { u2[j] = st[j]; u1[j] = st[512 + j]; }
            float* co = P.out + O_CONVS + ((size_t)l * 32 + b) * 2 * 512 + ch;
#pragma unroll
            for (int j = 0; j < 8; ++j) { co[j] = u1[j]; co[512 + j] = u0[j]; }
        } else {
#pragma unroll
            for (int j = 0; j < 8; ++j) { u1[j] = 0.f; u2[j] = 0.f; }
            if (t >= 1) { float a[8], c2[8]; unpack8(*(const u32x4*)(Hr - LDH + HCX + ch), a); unpack8(*(const u32x4*)(Hr - LDH + HCC + ch), c2);
#pragma unroll
                for (int j = 0; j < 8; ++j) u1[j] = a[j] * c2[j]; }
            if (t >= 2) { float a[8], c2[8]; unpack8(*(const u32x4*)(Hr - 2 * LDH + HCX + ch), a); unpack8(*(const u32x4*)(Hr - 2 * LDH + HCC + ch), c2);
#pragma unroll
                for (int j = 0; j < 8; ++j) u2[j] = a[j] * c2[j]; }
            if (t >= SEQ - 2) { float* co = P.out + O_CONV + (((size_t)l * 4 + b) * 2 + (t - (SEQ - 2))) * 512 + ch;
#pragma unroll
                for (int j = 0; j < 8; ++j) co[j] = u0[j]; }
        }
        const float* cw = P.conv_w + (size_t)l * 3 * 512 + ch; float z[8];
#pragma unroll
        for (int j = 0; j < 8; ++j) z[j] = cb[j] * (cw[j] * u2[j] + cw[512 + j] * u1[j] + cw[1024 + j] * u0[j]);
        *(u32x4*)((bf16_t*)(P.ws + WS_BR) + (size_t)m * 1536 + 512 + ch) = pack8(z);
    }
    {
        float v[8]; unpack8(*(const u32x4*)(Hr + HMQ + 8 * lane), v);
        float ss = 0.f;
#pragma unroll
        for (int j = 0; j < 8; ++j) ss += v[j] * v[j];
        ss += __shfl_xor(ss, 1); ss += __shfl_xor(ss, 2); ss += __shfl_xor(ss, 4); ss += __shfl_xor(ss, 8);
        const float ri = 1.0f / sqrtf(ss * (1.0f / 128.0f) + EPS);
        const float* gn = P.mem_q_norm + l * 128 + 8 * (lane & 15); float y[8];
#pragma unroll
        for (int j = 0; j < 8; ++j) y[j] = v[j] * ri * gn[j] * C2M;
        *(u32x4*)((bf16_t*)(P.ws + WS_MQ) + (size_t)m * 512 + 8 * lane) = pack8(y);
    }
}
DI void wincopy_rows(const Params& P, int l, int blk, int lane) {
    f32x4 v[7];
#pragma unroll
    for (int q = 0; q < 7; ++q) { const int r = 7 * blk + q, b = r / 511, i = r % 511; v[q] = *((const f32x4*)(P.cache_win + (((size_t)l * 32 + b) * 512 + i + 1) * 256) + lane); }
#pragma unroll
    for (int q = 0; q < 7; ++q) { const int r = 7 * blk + q, b = r / 511, i = r % 511; *((f32x4*)(P.out + O_WINS + (((size_t)l * 32 + b) * 512 + i) * 256) + lane) = v[q]; }
}
DI void memkv_row(const Params& P, int it, int lane) {
    const int lm = it / 1024, r = it % 1024, b = r >> 8, mm = r & 255;
    const float* src = (const float*)(P.ws + WS_MKVRAW) + ((size_t)lm * 1024 + r) * 1024;
    float* dst = P.out + O_MKV + ((size_t)lm * 1024 + r) * 1024;
    { float v[8]; const f32x4 a = *(const f32x4*)(src + 8 * lane), c = *(const f32x4*)(src + 8 * lane + 4);
      v[0] = a.x; v[1] = a.y; v[2] = a.z; v[3] = a.w; v[4] = c.x; v[5] = c.y; v[6] = c.z; v[7] = c.w;
      float ss = 0.f;
#pragma unroll
      for (int j = 0; j < 8; ++j) ss += v[j] * v[j];
      ss += __shfl_xor(ss, 1); ss += __shfl_xor(ss, 2); ss += __shfl_xor(ss, 4); ss += __shfl_xor(ss, 8);
      const float ri = 1.0f / sqrtf(ss * (1.0f / 128.0f) + EPS); const float* gn = P.mem_k_norm + lm * 128 + 8 * (lane & 15);
#pragma unroll
      for (int j = 0; j < 8; ++j) v[j] = v[j] * ri * gn[j];
      *(f32x4*)(dst + 8 * lane) = (f32x4){v[0], v[1], v[2], v[3]}; *(f32x4*)(dst + 8 * lane + 4) = (f32x4){v[4], v[5], v[6], v[7]};
      const int h = lane >> 4, d0 = 8 * (lane & 15);
      *(u32x4*)((bf16_t*)(P.ws + WS_MK) + ((((size_t)lm * 4 + b) * 4 + h) * 256 + mm) * 128 + d0) = pack8(v); }
    { float v[8]; const f32x4 a = *(const f32x4*)(src + 512 + 8 * lane), c = *(const f32x4*)(src + 512 + 8 * lane + 4);
      v[0] = a.x; v[1] = a.y; v[2] = a.z; v[3] = a.w; v[4] = c.x; v[5] = c.y; v[6] = c.z; v[7] = c.w;
      *(f32x4*)(dst + 512 + 8 * lane) = a; *(f32x4*)(dst + 512 + 8 * lane + 4) = c;
      const int h = lane >> 4, d0 = 8 * (lane & 15); bf16_t* vp = (bf16_t*)(P.ws + WS_MVT) + ((((size_t)lm * 4 + b) * 4 + h) * 128 + d0) * 256 + mm;
#pragma unroll
      for (int j = 0; j < 8; ++j) vp[(size_t)j * 256] = (bf16_t)f2bf(v[j]); }
}

template <int NB> DI void postb_q(const Params& P, int l, int m0, int lane, const u32x4 (&raw)[NB]) {
    const int sub = lane & 7;
    float gn[8];
#pragma unroll
    for (int j = 0; j < 8; ++j) gn[j] = P.q_norm[l * 64 + 8 * sub + j];
#pragma unroll
    for (int r = 0; r < NB; ++r) { const int m = m0 + r, pos = m & 4095;
        float v[8]; unpack8(raw[r], v); float ss = 0.f;
#pragma unroll
        for (int j = 0; j < 8; ++j) ss += v[j] * v[j];
        ss += __shfl_xor(ss, 1); ss += __shfl_xor(ss, 2); ss += __shfl_xor(ss, 4);
        const float ri = 1.0f / sqrtf(ss * (1.0f / 64.0f) + EPS); float y[8], yc[8], yr[8];
#pragma unroll
        for (int j = 0; j < 8; ++j) { y[j] = v[j] * ri * gn[j]; yc[j] = y[j] * C2; }
#pragma unroll
        for (int j = 0; j < 8; ++j) { const float o = __shfl_xor(y[j], 1); float rr = y[j];
            if (sub < 2) { float c, sn; rope_cs(pos, j, c, sn); rr = y[j] * c + (sub == 0 ? -o : o) * sn; }
            yr[j] = rr * C2; }
        *(u32x4*)((bf16_t*)(P.ws + WS_QC) + (size_t)m * 512 + 8 * lane) = pack8(yc);
        *(u32x4*)((bf16_t*)(P.ws + WS_QR) + (size_t)m * 512 + 8 * lane) = pack8(yr); }
}
template <int NB> DI void postb_kv(const Params& P, int l, int m0, int r0, int pass, int lane, LAS bf16_t* vt, const u32x4 (&raw)[NB]) {
    const int vi = pass * 8 + (lane >> 3), sub = lane & 7; const bool act = vi < 12; const int vic = act ? vi : 0;
    const int br = vic >> 2, kvsel = (vic >> 1) & 1, g = vic & 1, d0 = 8 * sub;
    const bool isk = (kvsel == 0) && (br >= 1);
    float gn[8];
#pragma unroll
    for (int j = 0; j < 8; ++j) gn[j] = P.k_norm[(l * 3 + (isk ? br : 1)) * 64 + d0 + j];
#pragma unroll
    for (int r = 0; r < NB; ++r) { const int m = m0 + r0 + r, b = m >> 12, t = m & 4095;
        float v[8]; unpack8(raw[r], v); float ss = 0.f;
#pragma unroll
        for (int j = 0; j < 8; ++j) ss += v[j] * v[j];
        ss += __shfl_xor(ss, 1); ss += __shfl_xor(ss, 2); ss += __shfl_xor(ss, 4);
        const float ri = 1.0f / sqrtf(ss * (1.0f / 64.0f) + EPS); float y[8];
#pragma unroll
        for (int j = 0; j < 8; ++j) y[j] = isk ? v[j] * ri * gn[j] : v[j];
#pragma unroll
        for (int j = 0; j < 8; ++j) { const float o = __shfl_xor(y[j], 1);
            if (isk && sub < 2) { float c, sn; rope_cs(t, j, c, sn); y[j] = y[j] * c + (sub == 0 ? -o : o) * sn; } }
        if (act) {
            if (br <= 1) { float* ro = P.out + O_ROWS + (((size_t)l * 4 + b) * 4096 + t) * 512 + (br * 2 + kvsel) * 128 + g * 64 + d0;
                *(f32x4*)ro = (f32x4){y[0], y[1], y[2], y[3]}; *(f32x4*)(ro + 4) = (f32x4){y[4], y[5], y[6], y[7]}; }
            if (br == 2 && t >= SEQ - 512) { float* wo = P.out + O_WIN + ((((size_t)l * 4 + b) * 512 + (t - (SEQ - 512))) * 2 + kvsel) * 128 + g * 64 + d0;
                *(f32x4*)wo = (f32x4){y[0], y[1], y[2], y[3]}; *(f32x4*)(wo + 4) = (f32x4){y[4], y[5], y[6], y[7]}; }
            if (br >= 1) {
                if (kvsel == 0) { bf16_t* kp = (bf16_t*)(P.ws + (br == 1 ? WS_KS : WS_KW)) + ((size_t)m * 2 + g) * 64 + d0; *(u32x4*)kp = pack8(y); }
                else { LAS bf16_t* vp = vt + (((br - 1) * 2 + g) * 64 + d0) * 8 + (r0 + r);
#pragma unroll
                    for (int j = 0; j < 8; ++j) vp[j * 8] = (bf16_t)f2bf(y[j]); } } } }
}
DI void postb_vflush(const Params& P, int m0, int lane, const LAS bf16_t* vt) {
    const int b = m0 >> 12, t0 = m0 & 4095;
#pragma unroll
    for (int i = 0; i < 4; ++i) { const int c = lane + 64 * i, brm = c >> 7, g = (c >> 6) & 1, d = c & 63;
        const u32x4 w = *(const LAS u32x4*)(vt + c * 8);
        *(u32x4*)((bf16_t*)(P.ws + (brm == 0 ? WS_VST : WS_VWT)) + ((size_t)(b * 2 + g) * 64 + d) * 4096 + t0) = w; }
}
template <int NB> DI void postb_conv(const Params& P, int l, int m0, int r0, int lane, const u32x4 (&rx)[NB + 2], const u32x4 (&rc)[NB + 2], const u32x4 (&rb)[NB]) {
    const int ch = 8 * lane;
    float w0[8], w1[8], w2[8];
    { const float* cw = P.conv_w + (size_t)l * 3 * 512 + ch;
#pragma unroll
      for (int j = 0; j < 8; ++j) { w0[j] = cw[j]; w1[j] = cw[512 + j]; w2[j] = cw[1024 + j]; } }
    float u[NB + 2][8];
#pragma unroll
    for (int r = 0; r < NB + 2; ++r) { float a[8], c[8]; unpack8(rx[r], a); unpack8(rc[r], c);
#pragma unroll
        for (int j = 0; j < 8; ++j) u[r][j] = a[j] * c[j]; }
#pragma unroll
    for (int r = 0; r < NB; ++r) { const int m = m0 + r0 + r, b = m >> 12, t = m & 4095; float cb[8], z[8]; unpack8(rb[r], cb);
#pragma unroll
        for (int j = 0; j < 8; ++j) z[j] = cb[j] * (w0[j] * u[r][j] + w1[j] * u[r + 1][j] + w2[j] * u[r + 2][j]);
        *(u32x4*)((bf16_t*)(P.ws + WS_BR) + (size_t)m * 1536 + 512 + ch) = pack8(z);
        if (t >= SEQ - 2) { float* co = P.out + O_CONV + (((size_t)l * 4 + b) * 2 + (t - (SEQ - 2))) * 512 + ch;
#pragma unroll
            for (int j = 0; j < 8; ++j) co[j] = u[r + 2][j]; } }
}
template <int NB> DI void postb_mq(const Params& P, int l, int m0, int lane, const u32x4 (&raw)[NB]) {
    float gn[8];
#pragma unroll
    for (int j = 0; j < 8; ++j) gn[j] = P.mem_q_norm[l * 128 + 8 * (lane & 15) + j] * C2M;
#pragma unroll
    for (int r = 0; r < NB; ++r) { float v[8]; unpack8(raw[r], v); float ss = 0.f;
#pragma unroll
        for (int j = 0; j < 8; ++j) ss += v[j] * v[j];
        ss += __shfl_xor(ss, 1); ss += __shfl_xor(ss, 2); ss += __shfl_xor(ss, 4); ss += __shfl_xor(ss, 8);
        const float ri = 1.0f / sqrtf(ss * (1.0f / 128.0f) + EPS); float y[8];
#pragma unroll
        for (int j = 0; j < 8; ++j) y[j] = v[j] * ri * gn[j];
        *(u32x4*)((bf16_t*)(P.ws + WS_MQ) + (size_t)(m0 + r) * 512 + 8 * lane) = pack8(y); }
}
#define OPAQ(x) asm volatile("" : "+v"(x))
DI void post_half(const Params& P, int l, int m1, int rofs, int lane0, LAS bf16_t* vt) {
    int lane = lane0; OPAQ(lane);
    const bf16_t* Hm = (const bf16_t*)(P.ws + WS_H) + (size_t)m1 * LDH; const int sub = lane & 7, t1 = m1 & 4095;
    u32x4 rq[4], rk0[4], rk1[4], rx[6], rc[6], rb[4], rm[4];
    const int vi1 = 8 + (lane >> 3), vic1 = vi1 < 12 ? vi1 : 0;
#pragma unroll
    for (int r = 0; r < 4; ++r) { const bf16_t* hr = Hm + (size_t)r * LDH;
        rq[r] = *(const u32x4*)(hr + HQ + 8 * lane); rk0[r] = *(const u32x4*)(hr + HKV + (lane >> 3) * 64 + 8 * sub); rk1[r] = *(const u32x4*)(hr + HKV + vic1 * 64 + 8 * sub);
        rb[r] = *(const u32x4*)(hr + HCB + 8 * lane); rm[r] = *(const u32x4*)(hr + HMQ + 8 * lane); }
#pragma unroll
    for (int r = 0; r < 6; ++r) { const bool ok = t1 + r - 2 >= 0; const bf16_t* hp = Hm + ((long)r - 2) * LDH + 8 * lane;
        rx[r] = ok ? *(const u32x4*)(hp + HCX) : (u32x4){0u, 0u, 0u, 0u}; rc[r] = ok ? *(const u32x4*)(hp + HCC) : (u32x4){0u, 0u, 0u, 0u}; }
    postb_q<4>(P, l, m1, lane, rq);
    OPAQ(lane); postb_kv<4>(P, l, m1 - rofs, rofs, 0, lane, vt, rk0);
    OPAQ(lane); postb_kv<4>(P, l, m1 - rofs, rofs, 1, lane, vt, rk1);
    OPAQ(lane); postb_conv<4>(P, l, m1 - rofs, rofs, lane, rx, rc, rb);
    OPAQ(lane); postb_mq<4>(P, l, m1, lane, rm);
}
DI void post_block8(const Params& P, int l, int m0, int lane, LAS bf16_t* vt) {
    post_half(P, l, m0, 0, lane, vt);
    post_half(P, l, m0 + 4, 4, lane, vt);
    LDS_WAIT();
    postb_vflush(P, m0, lane, vt);
    LDS_WAIT();
}

DI void post_conv8(const Params& P, int l, int m0, int lane0) {
#pragma unroll
    for (int hf = 0; hf < 2; ++hf) { int lane = lane0; OPAQ(lane);
        const int m1 = m0 + 4 * hf, t1 = m1 & 4095; const bf16_t* Hm = (const bf16_t*)(P.ws + WS_H) + (size_t)m1 * LDH;
        u32x4 rx[6], rc[6], rb[4];
#pragma unroll
        for (int r = 0; r < 4; ++r) rb[r] = *(const u32x4*)(Hm + (size_t)r * LDH + HCB + 8 * lane);
#pragma unroll
        for (int r = 0; r < 6; ++r) { const bool ok = t1 + r - 2 >= 0; const bf16_t* hp = Hm + ((long)r - 2) * LDH + 8 * lane;
            rx[r] = ok ? *(const u32x4*)(hp + HCX) : (u32x4){0u, 0u, 0u, 0u}; rc[r] = ok ? *(const u32x4*)(hp + HCC) : (u32x4){0u, 0u, 0u, 0u}; }
        postb_conv<4>(P, l, m1 - 4 * hf, 4 * hf, lane, rx, rc, rb); }
}
DI void cmpu_wave(const Params& P, int l, int it, int lane) {
    const int c = it >> 9, mt = (it >> 3) & 63, nt = it & 7, r32 = lane & 31, hi = lane >> 5;
    const int r = 32 * mt + r32, b = r >> 9, j = (r >> 1) & 255, g = r & 1;
    const bf16_t* ap = (const bf16_t*)(P.ws + WS_H) + ((size_t)b * 4096 + 16 * j) * LDH + HKV + c * 128 + g * 64 + 8 * hi;
    const bf16_t* bp = (const bf16_t*)(wl(P, l) + WL_W1C) + (size_t)c * 256 * 1024 + (size_t)(32 * nt + r32) * 1024 + 8 * hi;
    f32x16 acc = {};
#pragma unroll 2
    for (int s = 0; s < 16; ++s) {
        bf16x8 af[4], bf[4];
#pragma unroll
        for (int q = 0; q < 4; ++q) { af[q] = *(const bf16x8*)(ap + (size_t)s * LDH + 16 * q); bf[q] = *(const bf16x8*)(bp + 64 * s + 16 * q); }
#pragma unroll
        for (int q = 0; q < 4; ++q) acc = MFMA32(bf[q], af[q], acc);
    }
    bf16_t* U = (bf16_t*)(P.ws + WS_UP) + (size_t)c * 2048 * 256 + (size_t)r * 256 + 32 * nt;
#pragma unroll
    for (int rg = 0; rg < 4; ++rg) { u32x2 w; w.x = pk2(acc[4 * rg], acc[4 * rg + 1]); w.y = pk2(acc[4 * rg + 2], acc[4 * rg + 3]); *(u32x2*)(U + 8 * rg + 4 * hi) = w; }
}
template <class OutW>
DI void cmp_finalize_tile(const bf16_t* U, int Jn, int nblk, int seq, int g, int i0, const float* cbias  , const bf16_t* W2T  , const float* knorm  , int lane, const OutW& ow) {
    const int tr = lane & 15, q = lane >> 4, i = i0 + tr; const bool valid = i < nblk; const int ic = valid ? i : (nblk - 1);
    const bf16_t* u0p = U + ((size_t)(seq * Jn + ic) * 2 + g) * 256; const bf16_t* u1p = U + ((size_t)(seq * Jn + ic + 1) * 2 + g) * 256 + 128;
    bf16x8 bfr[4]; u32x4 ua[4], ub[4];
#pragma unroll
    for (int s = 0; s < 4; ++s) { ua[s] = *(const u32x4*)(u0p + 32 * s + 8 * q); ub[s] = *(const u32x4*)(u1p + 32 * s + 8 * q); }
#pragma unroll
    for (int s = 0; s < 4; ++s) { const int n0 = 32 * s + 8 * q; float a[8], b[8], h[8];
        unpack8(ua[s], a); unpack8(ub[s], b);
#pragma unroll
        for (int j = 0; j < 8; ++j) { const float x = a[j] + b[j] + cbias[n0 + j]; h[j] = x * sigmoidf_(x); }
        bfr[s] = __builtin_bit_cast(bf16x8, pack8(h)); }
    u32x4 w2[4][4];
#pragma unroll
    for (int ct = 0; ct < 4; ++ct)
#pragma unroll
        for (int s = 0; s < 4; ++s) w2[ct][s] = *(const u32x4*)(W2T + (size_t)(16 * ct + tr) * 128 + 32 * s + 8 * q);
#pragma unroll
    for (int ct = 0; ct < 4; ++ct) asm volatile("" : "+v"(w2[ct][0]), "+v"(w2[ct][1]), "+v"(w2[ct][2]), "+v"(w2[ct][3]));
    f32x4 acc[4];
#pragma unroll
    for (int ct = 0; ct < 4; ++ct) { acc[ct] = (f32x4){0.f, 0.f, 0.f, 0.f};
#pragma unroll
        for (int s = 0; s < 4; ++s) acc[ct] = MFMA16(__builtin_bit_cast(bf16x8, w2[ct][s]), bfr[s], acc[ct]); }
    if (knorm) { float ss = 0.f;
#pragma unroll
        for (int ct = 0; ct < 4; ++ct) ss += (acc[ct].x * acc[ct].x + acc[ct].y * acc[ct].y) + (acc[ct].z * acc[ct].z + acc[ct].w * acc[ct].w);
        ss += __shfl_xor(ss, 16); ss += __shfl_xor(ss, 32);
        const float ri = 1.0f / sqrtf(ss * (1.0f / 64.0f) + EPS);
#pragma unroll
        for (int ct = 0; ct < 4; ++ct) { const f32x4 gn = *(const f32x4*)(knorm + 16 * ct + 4 * q); acc[ct] = acc[ct] * ri * gn; } }
#pragma unroll
    for (int ct = 0; ct < 4; ++ct) ow(i, 16 * ct + 4 * q, acc[ct], valid);
}
DI void cmps_task(const Params& P, int it, int lane) {
    const int c = it & 1, l = (it >> 1) & 1, tile = (it >> 2) & 31, g = (it >> 7) & 1, b = it >> 8;
    const bf16_t* U = (const bf16_t*)(P.ws + WS_US) + (size_t)(l * 2 + c) * 32768 * 256;
    float* O = (float*)(P.ws + (c ? WS_VCS : WS_KCS)) + ((size_t)(l * 32 + b) * 2 + g) * 512 * 64;
    auto ow = [&](int i, int e0, f32x4 v, bool valid) { if (valid) *(f32x4*)(O + (size_t)i * 64 + e0) = v; };
    cmp_finalize_tile(U, 512, 511, b, g, 16 * tile, (const float*)(wl(P, l) + WL_CBF) + c * 128, (const bf16_t*)(wl(P, l) + WL_W2T) + (size_t)c * 64 * 128,
                      c ? nullptr : P.k_norm + (l * 3 + 0) * 64, lane, ow);
}
DI void cmpp_task(const Params& P, int l, int it, int lane) {
    const int c = it & 1, tile = (it >> 1) & 15, g = (it >> 5) & 1, b = it >> 6;
    const bf16_t* U = (const bf16_t*)(P.ws + WS_UP) + (size_t)c * 2048 * 256;
    bf16_t* KC = (bf16_t*)(P.ws + WS_KC) + (size_t)(b * 2 + g) * 256 * 64; bf16_t* VCT = (bf16_t*)(P.ws + WS_VCT) + (size_t)(b * 2 + g) * 64 * 256;
    auto ow = [&](int i, int e0, f32x4 v, bool valid) { if (!valid) v = (f32x4){0.f, 0.f, 0.f, 0.f};
        if (i < 256) { if (c == 0) { u32x2 w; w.x = pk2(v.x, v.y); w.y = pk2(v.z, v.w); *(u32x2*)(KC + (size_t)i * 64 + e0) = w; }
                       else { VCT[(size_t)(e0 + 0) * 256 + i] = (bf16_t)f2bf(v.x); VCT[(size_t)(e0 + 1) * 256 + i] = (bf16_t)f2bf(v.y); VCT[(size_t)(e0 + 2) * 256 + i] = (bf16_t)f2bf(v.z); VCT[(size_t)(e0 + 3) * 256 + i] = (bf16_t)f2bf(v.w); } } };
    cmp_finalize_tile(U, 256, 255, b, g, 16 * tile, (const float*)(wl(P, l) + WL_CBF) + c * 128, (const bf16_t*)(wl(P, l) + WL_W2T) + (size_t)c * 64 * 128,
                      c ? nullptr : P.k_norm + (l * 3 + 0) * 64, lane, ow);
}
constexpr int OC_STASH = 98304;
template <int HDIM, int HDV> struct FlashGeo {
    static constexpr int KP = HDIM * 2 + 16;
    static constexpr int KT = 64 * KP;
    static constexpr int VP = 144;
    static constexpr int VT = HDV * VP;
    static constexpr int BUF = KT + VT;
    static constexpr int NCH = HDIM / 64;
    static constexpr int NCV = HDV / 64;
};
template <int HDIM, int HDV, class TA>
DI void flash_pass(LAS unsigned char* lds, const bf16x8 (&qf)[HDIM / 16], f32x16 (&o)[HDV / 32], float& l_run, int ntiles, const TA& ta, float negB) {
    typedef FlashGeo<HDIM, HDV> G;
    const int tid = ltid(), lane = tid & 63, c32 = lane & 31, hi = lane >> 5;
    u32x4 kreg[G::NCH], vreg[G::NCV];
    auto issue = [&](int tile) {
#pragma unroll
        for (int i = 0; i < G::NCH; ++i) { const int id = tid + i * 512; kreg[i] = *(const u32x4*)ta.kptr(tile, id / (HDIM / 8), id % (HDIM / 8)); }
#pragma unroll
        for (int i = 0; i < G::NCV; ++i) { const int id = tid + i * 512; vreg[i] = *(const u32x4*)ta.vptr(tile, id >> 3, id & 7); } };
    auto commit = [&](LAS unsigned char* buf) {
#pragma unroll
        for (int i = 0; i < G::NCH; ++i) { const int id = tid + i * 512; *(LAS u32x4*)(buf + (id / (HDIM / 8)) * G::KP + (id % (HDIM / 8)) * 16) = kreg[i]; }
#pragma unroll
        for (int i = 0; i < G::NCV; ++i) { const int id = tid + i * 512;
            const int ch = id & 7; LAS unsigned char* vp = buf + G::KT + (id >> 3) * G::VP + (ch >> 1) * 32 + (ch & 1) * 8;
            *(LAS u32x2*)vp = (u32x2){vreg[i].x, vreg[i].y}; *(LAS u32x2*)(vp + 16) = (u32x2){vreg[i].z, vreg[i].w}; } };
    if (ntiles <= 0) return;
    issue(ta.tile(0)); commit(lds); __syncthreads();
    for (int it = 0; it < ntiles; ++it) {
        const int tile = ta.tile(it);
        const bool more = it + 1 < ntiles;
        if (more) issue(ta.tile(it + 1));
        const LAS unsigned char* buf = lds + (it & 1) * G::BUF;
        f32x16 p0, p1;
#pragma unroll
        for (int r = 0; r < 16; ++r) { p0[r] = negB; p1[r] = negB; }
        const LAS unsigned char* kb = buf + c32 * G::KP + hi * 16;
#pragma unroll
        for (int c = 0; c < HDIM / 16; ++c) {
            const bf16x8 a0 = *(const LAS bf16x8*)(kb + c * 32), a1 = *(const LAS bf16x8*)(kb + 32 * G::KP + c * 32);
            p0 = MFMA32(a0, qf[c], p0); p1 = MFMA32(a1, qf[c], p1);
            if ((c & 3) == 3) __builtin_amdgcn_sched_barrier(0);
        }
        ta.mask(tile, p0, p1);
        float ps = 0.f;
#pragma unroll
        for (int r = 0; r < 16; ++r) { p0[r] = fexp2(p0[r]); p1[r] = fexp2(p1[r]); ps += p0[r] + p1[r]; }
        l_run += ps;
        bf16x8 pf[2][2];
#pragma unroll
        for (int s = 0; s < 2; ++s) {
            u32x4 w0, w1;
            w0.x = pk2(p0[8 * s + 0], p0[8 * s + 1]); w0.y = pk2(p0[8 * s + 2], p0[8 * s + 3]); w0.z = pk2(p0[8 * s + 4], p0[8 * s + 5]); w0.w = pk2(p0[8 * s + 6], p0[8 * s + 7]);
            w1.x = pk2(p1[8 * s + 0], p1[8 * s + 1]); w1.y = pk2(p1[8 * s + 2], p1[8 * s + 3]); w1.z = pk2(p1[8 * s + 4], p1[8 * s + 5]); w1.w = pk2(p1[8 * s + 6], p1[8 * s + 7]);
            pf[0][s] = __builtin_bit_cast(bf16x8, w0); pf[1][s] = __builtin_bit_cast(bf16x8, w1);
        }
        const LAS unsigned char* vb = buf + G::KT + c32 * G::VP + hi * 16;
#pragma unroll
        for (int db = 0; db < HDV / 32; ++db)
#pragma unroll
            for (int kh = 0; kh < 2; ++kh)
#pragma unroll
                for (int s = 0; s < 2; ++s) {
                    const bf16x8 vf = *(const LAS bf16x8*)(vb + db * 32 * G::VP + kh * 64 + s * 32);
                    o[db] = MFMA32(vf, pf[kh][s], o[db]);
                }
        if (more) commit(lds + ((it + 1) & 1) * G::BUF);
        __syncthreads();
    }
}

template <class TA>
DI void flash_pass_pipe(LAS unsigned char* lds, const bf16x8 (&qf)[4], f32x16 (&o)[2], float& l_run, int ntiles, const TA& ta, const f32x16& cinit) {
    typedef FlashGeo<64, 64> G;
    const int tid = ltid(), lane = tid & 63, c32 = lane & 31, hi = lane >> 5;
    if (ntiles <= 0) return;
    u32x4 kA, vA;
    const int krow = tid >> 3, kch = tid & 7;
    auto issueA = [&](int tile) { kA = *(const u32x4*)ta.kptr(tile, krow, kch); vA = *(const u32x4*)ta.vptr(tile, krow, kch); };
    auto commit_ = [&](LAS unsigned char* buf, const u32x4& kreg, const u32x4& vreg) {
        *(LAS u32x4*)(buf + krow * G::KP + kch * 16) = kreg;
        LAS unsigned char* vp = buf + G::KT + krow * G::VP + (kch >> 1) * 32 + (kch & 1) * 8;
        *(LAS u32x2*)vp = (u32x2){vreg.x, vreg.y}; *(LAS u32x2*)(vp + 16) = (u32x2){vreg.z, vreg.w}; };
    auto qk = [&](const LAS unsigned char* buf, f32x16& p0, f32x16& p1) {
        const LAS unsigned char* kb = buf + c32 * G::KP + hi * 16;
        bf16x8 kf[8];
#pragma unroll
        for (int c = 0; c < 4; ++c) { kf[2 * c] = *(const LAS bf16x8*)(kb + c * 32); kf[2 * c + 1] = *(const LAS bf16x8*)(kb + 32 * G::KP + c * 32); }
        p0 = MFMA32(kf[0], qf[0], cinit); p1 = MFMA32(kf[1], qf[0], cinit);
#pragma unroll
        for (int c = 1; c < 4; ++c) { p0 = MFMA32(kf[2 * c], qf[c], p0); p1 = MFMA32(kf[2 * c + 1], qf[c], p1); } };
    const int last = ntiles - 1;
    auto img = [&](int t) { return lds + (t % 5) * G::BUF; };
    auto cl = [&](int t) { return ta.tile(t < ntiles ? t : last); };
    __syncthreads();
    issueA(cl(0)); commit_(img(0), kA, vA); issueA(cl(1)); commit_(img(1), kA, vA);
    issueA(cl(2)); commit_(img(2), kA, vA);
    __syncthreads();
    f32x16 s0, s1;
    qk(img(0), s0, s1);
    auto body = [&](int t, int offV, int offK) {
        f32x16 n0, n1;
        qk(lds + offK, n0, n1);
        const bool on = (t < ntiles) && ta.on(ta.tile(t < ntiles ? t : last));
        float ps = 0.f;
#pragma unroll
        for (int r = 0; r < 16; ++r) { s0[r] = fexp2(s0[r]); s1[r] = fexp2(s1[r]); ps += s0[r] + s1[r]; }
        l_run += on ? ps : 0.f;
        bf16x8 pf[2][2];
#pragma unroll
        for (int s = 0; s < 2; ++s) {
            u32x4 w0, w1;
            w0.x = pk2(s0[8 * s + 0], s0[8 * s + 1]); w0.y = pk2(s0[8 * s + 2], s0[8 * s + 3]); w0.z = pk2(s0[8 * s + 4], s0[8 * s + 5]); w0.w = pk2(s0[8 * s + 6], s0[8 * s + 7]);
            w1.x = pk2(s1[8 * s + 0], s1[8 * s + 1]); w1.y = pk2(s1[8 * s + 2], s1[8 * s + 3]); w1.z = pk2(s1[8 * s + 4], s1[8 * s + 5]); w1.w = pk2(s1[8 * s + 6], s1[8 * s + 7]);
            if (!on) { w0 = (u32x4){0u, 0u, 0u, 0u}; w1 = (u32x4){0u, 0u, 0u, 0u}; }
            pf[0][s] = __builtin_bit_cast(bf16x8, w0); pf[1][s] = __builtin_bit_cast(bf16x8, w1);
        }
        const LAS unsigned char* vb = lds + offV + G::KT + c32 * G::VP + hi * 16;
        bf16x8 vf[2][2][2];
#pragma unroll
        for (int db = 0; db < 2; ++db)
#pragma unroll
            for (int kh = 0; kh < 2; ++kh)
#pragma unroll
                for (int s = 0; s < 2; ++s) vf[db][kh][s] = *(const LAS bf16x8*)(vb + db * 32 * G::VP + kh * 64 + s * 32);
#pragma unroll
        for (int kh = 0; kh < 2; ++kh)
#pragma unroll
            for (int s = 0; s < 2; ++s)
#pragma unroll
                for (int db = 0; db < 2; ++db) o[db] = MFMA32(vf[db][kh][s], pf[kh][s], o[db]);
        s0 = n0; s1 = n1; };
    int o0 = 0, o1 = G::BUF, o2 = 2 * G::BUF, o3 = 3 * G::BUF, o4 = 4 * G::BUF;
    for (int t = 0; t < ntiles; t += 2) {
        issueA(cl(t + 3));
        body(t, o0, o1);
        commit_(lds + o3, kA, vA);
        __builtin_amdgcn_sched_barrier(0);
        issueA(cl(t + 4));
        body(t + 1, o1, o2);
        commit_(lds + o4, kA, vA);
        __syncthreads();
        { const int a = o0, b = o1; o0 = o2; o1 = o3; o2 = o4; o3 = a; o4 = b; }
    }
}

struct TaSlc {
    const bf16_t* K; const bf16_t* VT; int b, g, qb, qi, hi; unsigned long long sel; int t0;
    DI int tile(int i) const { return t0 + i; }
    DI bool on(int tile) const { return (sel >> tile) & 1ull; }
    DI const bf16_t* kptr(int tile, int row, int ch) const { return K + (((size_t)b * 4096 + 64 * tile + row) * 2 + g) * 64 + ch * 8; }
    DI const bf16_t* vptr(int tile, int d, int ch) const { return VT + ((size_t)(b * 2 + g) * 64 + d) * 4096 + 64 * tile + ch * 8; }
    DI void mask(int tile, f32x16& p0, f32x16& p1) const {
        const bool on = (sel >> tile) & 1ull;
        if (!on) {
#pragma unroll
            for (int r = 0; r < 16; ++r) { p0[r] = -INFINITY; p1[r] = -INFINITY; }
        } else if (tile == qb) {
#pragma unroll
            for (int r = 0; r < 16; ++r) { const int k = crow(r, hi); if (k > qi) p0[r] = -INFINITY; if (k + 32 > qi) p1[r] = -INFINITY; }
        }
    }
};
struct TaWin {
    const bf16_t* K; const bf16_t* VT; int b, g, qb, qi, hi; int t0;
    DI int tile(int i) const { return t0 - i; }
    DI bool on(int) const { return true; }
    DI const bf16_t* kptr(int tile, int row, int ch) const { return K + (((size_t)b * 4096 + 64 * tile + row) * 2 + g) * 64 + ch * 8; }
    DI const bf16_t* vptr(int tile, int d, int ch) const { return VT + ((size_t)(b * 2 + g) * 64 + d) * 4096 + 64 * tile + ch * 8; }
    DI void mask(int tile, f32x16& p0, f32x16& p1) const {
        if (tile == qb) {
#pragma unroll
            for (int r = 0; r < 16; ++r) { const int k = crow(r, hi); if (k > qi) p0[r] = -INFINITY; if (k + 32 > qi) p1[r] = -INFINITY; }
        } else if (tile == qb - 8) {
#pragma unroll
            for (int r = 0; r < 16; ++r) { const int k = crow(r, hi); if (k <= qi) p0[r] = -INFINITY; if (k + 32 <= qi) p1[r] = -INFINITY; }
        }
    }
};
DI void nsa_unit(const Params& P, int l, int b, int g, int qb, LAS unsigned char* lds, const unsigned long long sel) {
    const int tid = ltid(), wid = __builtin_amdgcn_readfirstlane(tid >> 6), lane = tid & 63, c32 = lane & 31, hi = lane >> 5;
    const int qi = 8 * wid + (c32 >> 2), head = 4 * g + (c32 & 3); const size_t m = (size_t)b * 4096 + 64 * qb + qi;
    bf16x8 qf[4];
    { const bf16_t* qp = (const bf16_t*)(P.ws + WS_QR) + m * 512 + head * 64 + 8 * hi;
#pragma unroll
      for (int c = 0; c < 4; ++c) qf[c] = *(const bf16x8*)(qp + 16 * c); }
    f32x16 os[2], ow[2];
    float ls, lw;
    float gq = fabsf(P.q_norm[l * 64 + lane]), gs = fabsf(P.k_norm[(l * 3 + 1) * 64 + lane]), gw = fabsf(P.k_norm[(l * 3 + 2) * 64 + lane]);
#pragma unroll
    for (int o_ = 1; o_ < 64; o_ <<= 1) { gq = fmaxf(gq, __shfl_xor(gq, o_)); gs = fmaxf(gs, __shfl_xor(gs, o_)); gw = fmaxf(gw, __shfl_xor(gw, o_)); }
    const float nbs = -(64.0f * C2 * 1.02f) * gq * gs, nbw = -(64.0f * C2 * 1.02f) * gq * gw;
    { os[0] = f32x16{}; os[1] = f32x16{}; ls = 0.f;
      TaSlc ta{(const bf16_t*)(P.ws + WS_KS), (const bf16_t*)(P.ws + WS_VST), b, g, qb, qi, hi, sel, 0};
      f32x16 cv;
#pragma unroll
      for (int r = 0; r < 16; ++r) cv[r] = nbs;
      flash_pass_pipe(lds, qf, os, ls, qb, ta, cv);
      TaSlc td{(const bf16_t*)(P.ws + WS_KS), (const bf16_t*)(P.ws + WS_VST), b, g, qb, qi, hi, sel, qb};
      flash_pass<64, 64>(lds, qf, os, ls, 1, td, nbs); }
    { ow[0] = f32x16{}; ow[1] = f32x16{}; lw = 0.f;
      TaWin td{(const bf16_t*)(P.ws + WS_KW), (const bf16_t*)(P.ws + WS_VWT), b, g, qb, qi, hi, qb};
      flash_pass<64, 64>(lds, qf, ow, lw, 1, td, nbw);
      TaWin tm{(const bf16_t*)(P.ws + WS_KW), (const bf16_t*)(P.ws + WS_VWT), b, g, qb, qi, hi, qb - 1};
      f32x16 cv;
#pragma unroll
      for (int r = 0; r < 16; ++r) cv[r] = nbw;
      flash_pass_pipe(lds, qf, ow, lw, qb < 7 ? qb : 7, tm, cv);
      if (qb >= 8) { TaWin te{(const bf16_t*)(P.ws + WS_KW), (const bf16_t*)(P.ws + WS_VWT), b, g, qb, qi, hi, qb - 8};
          flash_pass<64, 64>(lds, qf, ow, lw, 1, te, nbw); } }
    ls += __shfl_xor(ls, 32); lw += __shfl_xor(lw, 32);
    const bf16_t* Hr = (const bf16_t*)(P.ws + WS_H) + m * LDH + HNG;
    const float g0 = bf2f(Hr[head]), g1 = bf2f(Hr[8 + head]) * frcp(ls), g2 = bf2f(Hr[16 + head]) * frcp(lw);
    const LAS u32x2* ocs = (const LAS u32x2*)(lds + OC_STASH) + wid * 64 + lane;
    bf16_t* brp = (bf16_t*)(P.ws + WS_BR) + m * 1536 + head * 64;
#pragma unroll
    for (int db = 0; db < 2; ++db)
#pragma unroll
        for (int rg = 0; rg < 4; ++rg) { const int d = 32 * db + 8 * rg + 4 * hi; const u32x2 oc = ocs[(db * 4 + rg) * 512];
            const float v0 = g0 * bflo(oc.x) + g1 * os[db][4 * rg + 0] + g2 * ow[db][4 * rg + 0], v1 = g0 * bfhi(oc.x) + g1 * os[db][4 * rg + 1] + g2 * ow[db][4 * rg + 1];
            const float v2 = g0 * bflo(oc.y) + g1 * os[db][4 * rg + 2] + g2 * ow[db][4 * rg + 2], v3 = g0 * bfhi(oc.y) + g1 * os[db][4 * rg + 3] + g2 * ow[db][4 * rg + 3];
            u32x2 w; w.x = pk2(v0, v1); w.y = pk2(v2, v3); *(u32x2*)(brp + d) = w; }
}

struct TaMem {
    const bf16_t* K; const bf16_t* VT;
    DI int tile(int i) const { return i; }
    DI const bf16_t* kptr(int tile, int row, int ch) const { return K + (size_t)(64 * tile + row) * 128 + ch * 8; }
    DI const bf16_t* vptr(int tile, int d, int ch) const { return VT + (size_t)d * 256 + 64 * tile + ch * 8; }
    DI void mask(int, f32x16&, f32x16&) const {}
};
DI void mem_unit(const Params& P, int l, int b, int h, int qblk, LAS unsigned char* lds) {
    const int tid = ltid(), wid = __builtin_amdgcn_readfirstlane(tid >> 6), lane = tid & 63, c32 = lane & 31, hi = lane >> 5;
    const size_t m = (size_t)b * 4096 + 256 * qblk + 32 * wid + c32;
    bf16x8 qf[8];
    { const bf16_t* qp = (const bf16_t*)(P.ws + WS_MQ) + m * 512 + h * 128 + 8 * hi;
#pragma unroll
      for (int c = 0; c < 8; ++c) qf[c] = *(const bf16x8*)(qp + 16 * c); }
    const size_t hb = ((size_t)l * 4 + b) * 4 + h;
    bf16_t* brp = (bf16_t*)(P.ws + WS_BR) + m * 1536 + 1024 + h * 128;
    float gq = fmaxf(fabsf(P.mem_q_norm[l * 128 + lane]), fabsf(P.mem_q_norm[l * 128 + 64 + lane])), gk = fmaxf(fabsf(P.mem_k_norm[l * 128 + lane]), fabsf(P.mem_k_norm[l * 128 + 64 + lane]));
#pragma unroll
    for (int o_ = 1; o_ < 64; o_ <<= 1) { gq = fmaxf(gq, __shfl_xor(gq, o_)); gk = fmaxf(gk, __shfl_xor(gk, o_)); }
    const float nbm = -(128.0f * C2M * 1.02f) * gq * gk;
#pragma unroll 1
    for (int half = 0; half < 2; ++half) {
        f32x16 o[2]; o[0] = f32x16{}; o[1] = f32x16{};
        float ll = 0.f;
        TaMem ta{(const bf16_t*)(P.ws + WS_MK) + hb * 256 * 128, (const bf16_t*)(P.ws + WS_MVT) + hb * 128 * 256 + (size_t)half * 64 * 256};
        flash_pass<128, 64>(lds, qf, o, ll, 4, ta, nbm);
        ll += __shfl_xor(ll, 32); const float il = frcp(ll);
#pragma unroll
        for (int db = 0; db < 2; ++db)
#pragma unroll
            for (int rg = 0; rg < 4; ++rg) { const int d = 64 * half + 32 * db + 8 * rg + 4 * hi;
                u32x2 w; w.x = pk2(o[db][4 * rg] * il, o[db][4 * rg + 1] * il); w.y = pk2(o[db][4 * rg + 2] * il, o[db][4 * rg + 3] * il); *(u32x2*)(brp + d) = w; }
    }
}

constexpr int CA_KP = 144, CA_VP = 520, CA_K = 0, CA_V = 36864, CA_S = 36864 + 33280;
DI unsigned long long cmp_unit(const Params& P, int b, int g, int qb, LAS unsigned char* lds) {
    const int tid = ltid(), wid = __builtin_amdgcn_readfirstlane(tid >> 6), lane = tid & 63, c32 = lane & 31, hi = lane >> 5;
    const int qi = 8 * wid + (c32 >> 2), head = 4 * g + (c32 & 3), t = 64 * qb + qi; const size_t m = (size_t)b * 4096 + t;
    const int nkt = (4 * qb + 3 + 31) >> 5;
    __syncthreads();
    { const bf16_t* KC = (const bf16_t*)(P.ws + WS_KC) + (size_t)(b * 2 + g) * 256 * 64; const bf16_t* VCT = (const bf16_t*)(P.ws + WS_VCT) + (size_t)(b * 2 + g) * 64 * 256;
      u32x4 kr[4], vr[4];
#pragma unroll
      for (int i = 0; i < 4; ++i) { const int id = tid + i * 512; kr[i] = *(const u32x4*)(KC + (size_t)(id >> 3) * 64 + (id & 7) * 8); vr[i] = *(const u32x4*)(VCT + (size_t)(id >> 5) * 256 + (id & 31) * 8); }
      asm volatile("" : "+v"(kr[0]), "+v"(kr[1]), "+v"(kr[2]), "+v"(kr[3]), "+v"(vr[0]), "+v"(vr[1]), "+v"(vr[2]), "+v"(vr[3]));
#pragma unroll
      for (int i = 0; i < 4; ++i) { const int id = tid + i * 512;
          *(LAS u32x4*)(lds + CA_K + (id >> 3) * CA_KP + (id & 7) * 16) = kr[i];
          LAS unsigned char* vp = lds + CA_V + (id >> 5) * CA_VP + (id & 31) * 16;
          *(LAS u32x2*)vp = (u32x2){vr[i].x, vr[i].y}; *(LAS u32x2*)(vp + 8) = (u32x2){vr[i].z, vr[i].w}; } }
    bf16x8 qf[4];
    { const bf16_t* qp = (const bf16_t*)(P.ws + WS_QC) + m * 512 + head * 64 + 8 * hi;
#pragma unroll
      for (int c = 0; c < 4; ++c) qf[c] = *(const bf16x8*)(qp + 16 * c); }
    __syncthreads();
    const int lim = (t - 31) >> 4;
    f32x16 sc[8];
    float mx = -INFINITY;
#pragma unroll
    for (int kt = 0; kt < 8; ++kt) {
        sc[kt] = f32x16{};
        if (kt < nkt) {
            const LAS unsigned char* kb = lds + CA_K + (32 * kt + c32) * CA_KP + hi * 16;
#pragma unroll
            for (int c = 0; c < 4; ++c) sc[kt] = MFMA32(*(const LAS bf16x8*)(kb + c * 32), qf[c], sc[kt]);
#pragma unroll
            for (int r = 0; r < 16; ++r) { const int i = 32 * kt + crow(r, hi); if (i > lim) sc[kt][r] = -INFINITY; mx = fmaxf(mx, sc[kt][r]); }
        }
    }
    mx = fmaxf(mx, __shfl_xor(mx, 32));
    const float mu = (mx == -INFINITY) ? 0.f : mx;
    float sum = 0.f;
#pragma unroll
    for (int kt = 0; kt < 8; ++kt) if (kt < nkt) {
#pragma unroll
        for (int r = 0; r < 16; ++r) { sc[kt][r] = fexp2(sc[kt][r] - mu); sum += sc[kt][r]; } }
    sum += __shfl_xor(sum, 32);
    const float inv = sum > 0.f ? 1.0f / sum : 0.f;
    f32x16 o[2]; o[0] = f32x16{}; o[1] = f32x16{};
    float sa[8][4], se[8][4];
#pragma unroll
    for (int kt = 0; kt < 8; ++kt)
#pragma unroll
        for (int rg = 0; rg < 4; ++rg) { sa[kt][rg] = 0.f; se[kt][rg] = 0.f; }
#pragma unroll
    for (int kt = 0; kt < 8; ++kt) if (kt < nkt) {
#pragma unroll
        for (int r = 0; r < 16; ++r) sc[kt][r] *= inv;
#pragma unroll
        for (int rg = 0; rg < 4; ++rg) { sa[kt][rg] = (sc[kt][4 * rg] + sc[kt][4 * rg + 1]) + (sc[kt][4 * rg + 2] + sc[kt][4 * rg + 3]); se[kt][rg] = sc[kt][4 * rg + 3]; }
        const LAS unsigned char* vb = lds + CA_V + c32 * CA_VP + kt * 64 + hi * 8;
#pragma unroll
        for (int s = 0; s < 2; ++s) { u32x4 w; w.x = pk2(sc[kt][8 * s + 0], sc[kt][8 * s + 1]); w.y = pk2(sc[kt][8 * s + 2], sc[kt][8 * s + 3]); w.z = pk2(sc[kt][8 * s + 4], sc[kt][8 * s + 5]); w.w = pk2(sc[kt][8 * s + 6], sc[kt][8 * s + 7]);
            const bf16x8 pf = __builtin_bit_cast(bf16x8, w);
#pragma unroll
            for (int db = 0; db < 2; ++db) { const LAS unsigned char* vp = vb + db * 32 * CA_VP + s * 32;
                const s16x4 lo = *(const LAS s16x4*)vp, hh = *(const LAS s16x4*)(vp + 16);
                o[db] = MFMA32(__builtin_shufflevector(lo, hh, 0, 1, 2, 3, 4, 5, 6, 7), pf, o[db]); } } }
    { LAS u32x2* ocs = (LAS u32x2*)(lds + OC_STASH) + wid * 64 + lane;
#pragma unroll
      for (int db = 0; db < 2; ++db)
#pragma unroll
          for (int rg = 0; rg < 4; ++rg) { u32x2 w; w.x = pk2(o[db][4 * rg], o[db][4 * rg + 1]); w.y = pk2(o[db][4 * rg + 2], o[db][4 * rg + 3]); ocs[(db * 4 + rg) * 512] = w; } }
    unsigned long long mask;
    if (qb < 16) mask = (2ull << qb) - 1ull;
    else {
        LAS float* scl = (LAS float*)(lds + CA_S) + wid * 576 + (c32 >> 2) * 72;
        float prevx = 0.f;
#pragma unroll
        for (int kt = 0; kt < 8; ++kt)
#pragma unroll
            for (int rg = 0; rg < 4; ++rg) {
                const float a = sa[kt][rg], e = se[kt][rg];
                const float x = __shfl_xor(e, 32);
                float sp = a + (hi ? x : prevx);
                prevx = x;
                sp += __shfl_xor(sp, 1); sp += __shfl_xor(sp, 2);
                const int j = 8 * kt + 2 * rg + hi;
                if ((c32 & 3) == 0) scl[j] = (j >= 1 && j <= qb - 2) ? __uint_as_float(((__float_as_uint(sp) & ~63u) | (unsigned)(63 - j)) + 64u) : __uint_as_float(0u);
            }
        LDS_WAIT();
        const int sub = (lane & 3) | (hi << 2);
        unsigned own[8]; int cnt[8];
        const LAS unsigned* sclu = (const LAS unsigned*)scl;
#pragma unroll
        for (int s = 0; s < 8; ++s) { own[s] = sclu[8 * s + sub]; cnt[s] = 0; }
        for (int jj = 0; jj < 64; ++jj) { const unsigned v = sclu[jj];
#pragma unroll
            for (int s = 0; s < 8; ++s) cnt[s] += (v > own[s]) ? 1 : 0; }
        mask = 0ull; const int sh = 4 * (c32 >> 2);
#pragma unroll
        for (int s = 0; s < 8; ++s) { const unsigned long long bl = __ballot(own[s] != 0u && cnt[s] < 13);
            const unsigned long long byte = ((bl >> sh) & 0xFull) | (((bl >> (32 + sh)) & 0xFull) << 4); mask |= byte << (8 * s); }
        mask |= 1ull | (1ull << qb) | (1ull << (qb - 1));
    }
    return mask;
}
template <int HDIM, int NHQ, class KF, class VF, class MF>
DI void lds_attn(LAS unsigned char* stg, const LAS float* qs, LAS float* sb, int smax, LAS float* invs, LAS float* part, LAS float* ob, int nkeys, const KF& kf, const VF& vf, const MF& valid) {
    constexpr int CH = (HDIM == 64) ? 512 : 256, KP = HDIM * 2 + 16, VP = HDIM * 2, CPR = HDIM / 4  , NLD = CH * CPR / 512;
    constexpr int PAIRS = CH * NHQ, PPT = PAIRS >= 512 ? PAIRS / 512 : 1, SPLIT = PAIRS >= 512 ? 1 : 512 / PAIRS, DPT = HDIM / SPLIT, QP = HDIM + 4  ;
    const int tid = ltid(), wid = tid >> 6, lane = tid & 63;
    const bool two = nkeys > CH;
    f32x4 bA[NLD], bB[NLD];
    const int row0 = tid / CPR, cc0 = tid % CPR;
#define LA_ISSUE(bank, fn, c) do { _Pragma("unroll") for (int i_ = 0; i_ < NLD; ++i_) { const int key_ = (c) * CH + row0 + i_ * (512 / CPR); bank[i_] = (key_ < nkeys) ? ((const f32x4*)fn(key_))[cc0] : (f32x4){0.f, 0.f, 0.f, 0.f}; } } while (0)
#define LA_COMMIT(bank, pitch) do { LAS unsigned char* wb_ = stg + row0 * (pitch) + cc0 * 8; _Pragma("unroll") for (int i_ = 0; i_ < NLD; ++i_) { u32x2 w_; w_.x = pk2(bank[i_].x, bank[i_].y); w_.y = pk2(bank[i_].z, bank[i_].w); *(LAS u32x2*)(wb_ + i_ * (512 / CPR) * (pitch)) = w_; } } while (0)
    auto scores = [&](int c) {
        const int pr0 = (SPLIT == 1) ? tid : tid / SPLIT, h = pr0 % NHQ, sp = (SPLIT == 1) ? 0 : tid % SPLIT;
        const LAS unsigned char* kr = stg + (pr0 / NHQ) * KP + sp * DPT * 2; const LAS float* qp = qs + h * QP + sp * DPT; float a[PPT];
#pragma unroll
        for (int j = 0; j < PPT; ++j) a[j] = 0.f;
#pragma unroll 2
        for (int d = 0; d < DPT; d += 8) { const f32x4 q0 = *(const LAS f32x4*)(qp + d), q1 = *(const LAS f32x4*)(qp + d + 4);
#pragma unroll
            for (int j = 0; j < PPT; ++j) { float kv[8]; unpack8(*(const LAS u32x4*)(kr + j * (512 / NHQ) * KP + d * 2), kv);
                a[j] += (kv[0] * q0.x + kv[1] * q0.y) + (kv[2] * q0.z + kv[3] * q0.w) + (kv[4] * q1.x + kv[5] * q1.y) + (kv[6] * q1.z + kv[7] * q1.w); } }
#pragma unroll
        for (int j = 0; j < PPT; ++j) { float aj = a[j]; const int key = c * CH + pr0 / NHQ + j * (512 / NHQ);
            if (SPLIT > 1) {
#pragma unroll
                for (int o = 1; o < SPLIT; o <<= 1) aj += __shfl_xor(aj, o); }
            if (key < nkeys && sp == 0) sb[h * smax + key] = valid(key) ? aj : -INFINITY; } };
    constexpr int LPP = NHQ * HDIM / 4, NP = 512 / LPP, KPP = CH / NP;
    const int pp = tid / LPP, w = tid % LPP, h = w / (HDIM / 4), d4 = w % (HDIM / 4); f32x4 acc = {0.f, 0.f, 0.f, 0.f};
    auto pv = [&](int c) {
        const int k0 = c * CH + pp * KPP; const LAS unsigned char* vr = stg + pp * KPP * VP + d4 * 8; const LAS float* pr = sb + h * smax + k0;
#pragma unroll 4
        for (int kk = 0; kk < KPP; kk += 4) { if (k0 + kk < nkeys) { f32x4 p4 = *(const LAS f32x4*)(pr + kk);
            if (k0 + kk + 3 >= nkeys) { if (k0 + kk + 1 >= nkeys) p4.y = 0.f; if (k0 + kk + 2 >= nkeys) p4.z = 0.f; p4.w = 0.f; }
            const float pe[4] = {p4.x, p4.y, p4.z, p4.w};
#pragma unroll
            for (int e = 0; e < 4; ++e) { const u32x2 vv = *(const LAS u32x2*)(vr + (kk + e) * VP); const float p = pe[e];
                acc.x += p * bflo(vv.x); acc.y += p * bfhi(vv.x); acc.z += p * bflo(vv.y); acc.w += p * bfhi(vv.y); } } } };
    LA_ISSUE(bA, kf, 0);
    if (two) LA_ISSUE(bB, kf, 1); else LA_ISSUE(bB, vf, 0);
    __syncthreads();
    LA_COMMIT(bA, KP);
    if (two) LA_ISSUE(bA, vf, 0);
    __syncthreads();
    scores(0);
    if (two) { __syncthreads(); LA_COMMIT(bB, KP); LA_ISSUE(bB, vf, 1); __syncthreads(); scores(1); }
    __syncthreads();
    if (wid < NHQ) { LAS float* sr = sb + wid * smax; float mx = -INFINITY;
        for (int k = lane; k < nkeys; k += 64) mx = fmaxf(mx, sr[k]);
#pragma unroll
        for (int o = 1; o < 64; o <<= 1) mx = fmaxf(mx, __shfl_xor(mx, o));
        float sum = 0.f;
        for (int k = lane; k < nkeys; k += 64) { const float e = fexp2(sr[k] - mx); sr[k] = e; sum += e; }
        sum = wave_sum(sum);
        if (lane == 0) invs[wid] = 1.0f / sum; }
    if (two) { LA_COMMIT(bA, VP); __syncthreads(); pv(0); __syncthreads(); LA_COMMIT(bB, VP); __syncthreads(); pv(1); }
    else { LA_COMMIT(bB, VP); __syncthreads(); pv(0); }
#undef LA_ISSUE
#undef LA_COMMIT
    *(LAS f32x4*)(part + (size_t)tid * 4) = acc;
    __syncthreads();
    if (tid < NHQ * HDIM) { const int hh = tid / HDIM, d = tid % HDIM; float s2 = 0.f;
#pragma unroll
        for (int q = 0; q < NP; ++q) s2 += part[(q * LPP + hh * (HDIM / 4) + (d >> 2)) * 4 + (d & 3)];
        ob[tid] = s2 * invs[hh]; }
    __syncthreads();
}
DI void sample_nsa_unit(const Params& P, int l, int b, int g, LAS unsigned char* lds) {
    const int tid = ltid();
    LAS float* qs_c = (LAS float*)(lds + 73728); LAS float* qs_r = qs_c + 272; LAS float* sb = qs_r + 272; LAS float* invs = sb + 4160; LAS float* part = invs + 8;
    LAS float* ob_c = part + 2048; LAS float* ob_s = ob_c + 256; LAS float* ob_w = ob_s + 256; LAS float* imp = ob_w + 256; LAS float* scj = imp + 512; LAS int* flag = (LAS int*)(scj + 160); LAS int* sl = flag + 160; LAS unsigned long long* kbase = (LAS unsigned long long*)(sl + 16);
    const size_t m = (size_t)MP + b;
    __syncthreads();
    if (tid < 256) { const int h = tid >> 6, d = tid & 63; qs_c[h * 68 + d] = bf2f(((const bf16_t*)(P.ws + WS_QC))[m * 512 + (4 * g + h) * 64 + d]); qs_r[h * 68 + d] = bf2f(((const bf16_t*)(P.ws + WS_QR))[m * 512 + (4 * g + h) * 64 + d]); }
    __syncthreads();
    { const float* KCb = (const float*)(P.ws + WS_KCS) + ((size_t)(l * 32 + b) * 2 + g) * 512 * 64; const float* VCb = (const float*)(P.ws + WS_VCS) + ((size_t)(l * 32 + b) * 2 + g) * 512 * 64;
      auto kf = [&](int key) { return KCb + (size_t)key * 64; }; auto vf = [&](int key) { return VCb + (size_t)key * 64; }; auto va = [&](int) { return true; };
      lds_attn<64, 4>(lds, qs_c, sb, 1040, invs, part, ob_c, 511, kf, vf, va); }
    for (int i = tid; i < 512; i += 512) imp[i] = (i < 511) ? (sb[i] * invs[0] + sb[1040 + i] * invs[1]) + (sb[2080 + i] * invs[2] + sb[3120 + i] * invs[3]) : 0.f;
    __syncthreads();
    if (tid < 129) { float s = 0.f;
#pragma unroll
        for (int q = -1; q < 4; ++q) { const int i = 4 * tid + q; if (i >= 0 && i < 511) s += imp[i]; }
        scj[tid] = s; }
    __syncthreads();
    if (tid < 129) { int f = 0;
        if (tid == 0 || tid >= 127) f = 1;
        else { const float mine = scj[tid]; int cnt = 0;
            for (int j = 1; j <= 126; ++j) { const float v = scj[j]; cnt += ((v > mine) || (v == mine && j < tid)) ? 1 : 0; }
            f = cnt < 13; }
        flag[tid] = f; }
    __syncthreads();
    if (tid < 64) { const int f0 = flag[tid], f1 = flag[64 + tid];
        const unsigned long long b0 = __ballot(f0), b1 = __ballot(f1), lt = (1ull << tid) - 1ull;
        if (tid < 16) sl[tid] = 128;
        const int p0 = __popcll(b0 & lt), p1 = __popcll(b0) + __popcll(b1 & lt);
        if (f0 && p0 < 16) sl[p0] = tid;
        if (f1 && p1 < 16) sl[p1] = 64 + tid; }
    __syncthreads();
    if (tid < 16) { const int kp0 = 64 * sl[tid]; const int* pt = P.page_table + b * 64;
        kbase[tid] = (kp0 < PAST) ? ((unsigned long long)pt[kp0 >> 7] * 128 + (unsigned)(kp0 & 127)) * 512ull : ~0ull; }
    __syncthreads();
    { const float* cache = P.cache_nsa + (size_t)l * NPHYS * (128 * 512);
      const float* newrow = P.out + O_ROWSS + ((size_t)l * 32 + b) * 512;
      auto kpos = [&](int key) { return 64 * sl[key >> 6] + (key & 63); };
      auto kf = [&](int key) { const unsigned long long o = kbase[key >> 6]; return (o != ~0ull) ? cache + (size_t)o + (size_t)(key & 63) * 512 + 2 * 128 + g * 64 : newrow + 2 * 128 + g * 64; };
      auto vf = [&](int key) { const unsigned long long o = kbase[key >> 6]; return (o != ~0ull) ? cache + (size_t)o + (size_t)(key & 63) * 512 + 3 * 128 + g * 64 : newrow + 3 * 128 + g * 64; };
      auto va = [&](int key) { return kpos(key) <= PAST; };
      lds_attn<64, 4>(lds, qs_r, sb, 1040, invs, part, ob_s, 1024, kf, vf, va); }
    if (tid < 256) { const int h = tid >> 6, d = tid & 63, head = 4 * g + h; float* so = (float*)(P.ws + WS_SOUT) + (size_t)b * 1536 + head * 64 + d; so[0] = ob_c[tid]; so[512] = ob_s[tid]; }
}
DI void sample_win_unit(const Params& P, int l, int b, int g, LAS unsigned char* lds) {
    const int tid = ltid();
    LAS float* qs_r = (LAS float*)(lds + 73728); LAS float* sb = qs_r + 272; LAS float* invs = sb + 4160; LAS float* part = invs + 8; LAS float* ob_w = part + 2048;
    const size_t m = (size_t)MP + b;
    __syncthreads();
    if (tid < 256) { const int h = tid >> 6, d = tid & 63; qs_r[h * 68 + d] = bf2f(((const bf16_t*)(P.ws + WS_QR))[m * 512 + (4 * g + h) * 64 + d]); }
    __syncthreads();
    const float* wb = P.out + O_WINS + ((size_t)l * 32 + b) * 512 * 256;
    auto kf = [&](int key) { return wb + (size_t)key * 256 + g * 64; }; auto vf = [&](int key) { return wb + (size_t)key * 256 + 128 + g * 64; }; auto va = [&](int) { return true; };
    lds_attn<64, 4>(lds, qs_r, sb, 1040, invs, part, ob_w, 512, kf, vf, va);
    if (tid < 256) { const int h = tid >> 6, d = tid & 63, head = 4 * g + h; ((float*)(P.ws + WS_SOUT))[(size_t)b * 1536 + 1024 + head * 64 + d] = ob_w[tid]; }
}
DI void sample_combine_row(const Params& P, int b, int lane) {
    const size_t m = (size_t)MP + b; const float* so = (const float*)(P.ws + WS_SOUT) + (size_t)b * 1536 + 8 * lane; const bf16_t* Hr = (const bf16_t*)(P.ws + WS_H) + m * LDH + HNG; const int head = lane >> 3;
    const float g0 = bf2f(Hr[head]), g1 = bf2f(Hr[8 + head]), g2 = bf2f(Hr[16 + head]); float v[8];
#pragma unroll
    for (int j = 0; j < 8; ++j) v[j] = g0 * so[j] + g1 * so[512 + j] + g2 * so[1024 + j];
    *(u32x4*)((bf16_t*)(P.ws + WS_BR) + m * 1536 + 8 * lane) = pack8(v);
}
DI void sample_mem_unit(const Params& P, int l, int b, int h, LAS unsigned char* lds) {
    const int tid = ltid();
    LAS float* qs = (LAS float*)(lds + 73728); LAS float* sb = qs + 128; LAS float* invs = sb + 256; LAS float* part = invs + 8; LAS float* ob = part + 2048;
    const size_t m = (size_t)MP + b;
    __syncthreads();
    if (tid < 128) qs[tid] = bf2f(((const bf16_t*)(P.ws + WS_MQ))[m * 512 + h * 128 + tid]);
    __syncthreads();
    const float* mk = P.cache_mem + ((size_t)l * 32 + b) * 256 * 1024 + h * 128;
    auto kf = [&](int key) { return mk + (size_t)key * 1024; }; auto vf = [&](int key) { return mk + (size_t)key * 1024 + 512; }; auto va = [&](int) { return true; };
    lds_attn<128, 1>(lds, qs, sb, 256, invs, part, ob, 256, kf, vf, va);
    if (tid < 128) ((bf16_t*)(P.ws + WS_BR))[m * 1536 + 1024 + h * 128 + tid] = (bf16_t)f2bf(ob[tid]);
}

DI void s_inproj_item(const Params& P, int l, int it, LAS unsigned char* lds) {
    const bf16_t* XB = (const bf16_t*)(P.ws + WS_XB) + (size_t)MP * 1024; const bf16_t* W = (const bf16_t*)(wl(P, l) + WL_WIN);
    auto ap = [&](int, int m, int k) { return XB + (size_t)m * 1024 + k; }; auto bp = [&](int, int n, int k) { return W + (size_t)(32 * it + n) * 1024 + k; };
    small_gemm_tile<1>(lds, 1024, ap, bp);
    const LAS float* fin = (const LAS float*)(lds + 32768); const float* ssq = (l == 0 ? (const float*)(P.ws + WS_RINV) : (const float*)(P.ws + WS_SSQ) + 2 * SSQ_STRIDE) + MP; bf16_t* H = (bf16_t*)(P.ws + WS_H) + (size_t)MP * LDH;
    for (int e = ltid(); e < 1024; e += 512) { const int m = e >> 5, n = e & 31, col = 32 * it + n; float v = fin[n * 32 + m] * rinv_of(ssq[m]); if (col >= HMG) v = sigmoidf_(v); H[(size_t)m * LDH + col] = (bf16_t)f2bf(v); }
}
DI void s_branch_item(const Params& P, int l, int it, LAS unsigned char* lds) {
    const bf16_t* BR = (const bf16_t*)(P.ws + WS_BR) + (size_t)MP * 1536; const bf16_t* W = (const bf16_t*)(wl(P, l) + WL_WBR);
    auto ap = [&](int seg, int m, int k) { return BR + (size_t)m * 1536 + seg * 512 + k; }; auto bp = [&](int seg, int n, int k) { return W + (size_t)(32 * it + n) * 1536 + seg * 512 + k; };
    small_gemm_tile<3>(lds, 512, ap, bp);
    const LAS float* fin = (const LAS float*)(lds + 3 * 32768); const bf16_t* H = (const bf16_t*)(P.ws + WS_H) + (size_t)MP * LDH + HMG; bf16_t* MG = (bf16_t*)(P.ws + WS_MG) + (size_t)MP * 1024;
    for (int e = ltid(); e < 1024; e += 512) { const int m = e >> 5, n = e & 31, col = 32 * it + n; float v = 0.f;
#pragma unroll
        for (int s = 0; s < 3; ++s) v += fin[s * 1024 + n * 32 + m] * bf2f(H[(size_t)m * LDH + s * 1024 + col]);
        MG[(size_t)m * 1024 + col] = (bf16_t)f2bf(v); }
}
DI void s_wout_item(const Params& P, int l, int it, LAS unsigned char* lds) {
    const bf16_t* MG = (const bf16_t*)(P.ws + WS_MG) + (size_t)MP * 1024; const bf16_t* W = (const bf16_t*)(wl(P, l) + WL_WOUT);
    auto ap = [&](int, int m, int k) { return MG + (size_t)m * 1024 + k; }; auto bp = [&](int, int n, int k) { return W + (size_t)(32 * it + n) * 1024 + k; };
    small_gemm_tile<1>(lds, 1024, ap, bp);
    const LAS float* fin = (const LAS float*)(lds + 32768); float* HR = (float*)(P.ws + WS_HRES) + (size_t)MP * 1024; bf16_t* HB = (bf16_t*)(P.ws + WS_HB) + (size_t)MP * 1024; float* ssq = (float*)(P.ws + WS_SSQ) + (size_t)l * SSQ_STRIDE + MP;
    for (int e = ltid(); e < 1024; e += 512) { const int m = e >> 5, n = e & 31, col = 32 * it + n; const float v = xrow_in(P, l, MP + m)[col] + fin[n * 32 + m];
        HR[(size_t)m * 1024 + col] = v; HB[(size_t)m * 1024 + col] = (bf16_t)f2bf(v); float ss = v * v;
#pragma unroll
        for (int o_ = 1; o_ < 32; o_ <<= 1) ss += __shfl_xor(ss, o_);
        if (n == 0) atomicAdd(ssq + m, ss); }
}
DI void s_gateup_item(const Params& P, int l, int it, LAS unsigned char* lds) {
    const bf16_t* HB = (const bf16_t*)(P.ws + WS_HB) + (size_t)MP * 1024; const bf16_t* W = (const bf16_t*)(wl(P, l) + WL_WGU);
    auto ap = [&](int, int m, int k) { return HB + (size_t)m * 1024 + k; };
    auto bp = [&](int, int n, int k) { const int f = 16 * it + (n & 15); return W + (size_t)((f >> 7) * 256 + (f & 127) + (n >> 4) * 128) * 1024 + k; };
    small_gemm_tile<1>(lds, 1024, ap, bp);
    const LAS float* fin = (const LAS float*)(lds + 32768); const float* ssq = (const float*)(P.ws + WS_SSQ) + (size_t)l * SSQ_STRIDE + MP; bf16_t* ACT = (bf16_t*)(P.ws + WS_ACT) + (size_t)MP * D_FF;
    { const int e = ltid(), m = e >> 4, j = e & 15; const float ri = rinv_of(ssq[m]), gg = fin[j * 32 + m] * ri, uu = fin[(16 + j) * 32 + m] * ri; ACT[(size_t)m * D_FF + 16 * it + j] = (bf16_t)f2bf(gg * sigmoidf_(gg) * uu); }
}
DI void s_down_item(const Params& P, int l, int it, LAS unsigned char* lds) {
    const bf16_t* ACT = (const bf16_t*)(P.ws + WS_ACT) + (size_t)MP * D_FF; const bf16_t* W = (const bf16_t*)(wl(P, l) + WL_WDN);
    auto ap = [&](int, int m, int k) { return ACT + (size_t)m * D_FF + k; }; auto bp = [&](int, int n, int k) { return W + (size_t)(32 * it + n) * D_FF + k; };
    small_gemm_tile<1>(lds, D_FF, ap, bp);
    const LAS float* fin = (const LAS float*)(lds + 32768); const float* HR = (const float*)(P.ws + WS_HRES) + (size_t)MP * 1024;
    float* O = (l == 0) ? (float*)(P.ws + WS_XNEXT) + (size_t)MP * 1024 : P.out + O_YS;
    bf16_t* XB = (bf16_t*)(P.ws + WS_XB) + (size_t)MP * 1024; float* ssq = (float*)(P.ws + WS_SSQ) + 2 * SSQ_STRIDE + MP;
    for (int e = ltid(); e < 1024; e += 512) { const int m = e >> 5, n = e & 31, col = 32 * it + n; const float v = HR[(size_t)m * 1024 + col] + fin[n * 32 + m]; O[(size_t)m * 1024 + col] = v;
        if (l == 0) { XB[(size_t)m * 1024 + col] = (bf16_t)f2bf(v); float ss = v * v;
#pragma unroll
            for (int o_ = 1; o_ < 32; o_ <<= 1) ss += __shfl_xor(ss, o_);
            if (n == 0) atomicAdd(ssq + m, ss); } }
}
#ifndef N_LAUNCH_MODE
#define N_LAUNCH_MODE 0
#endif
constexpr int NPHASE = 20;
#ifndef PROBE_SITE
#define PROBE_SITE (-1)
#endif
#ifndef PROBE_MASK
#define PROBE_MASK 0
#endif
#define REPS(site) ((PROBE_SITE == (site) || ((PROBE_MASK >> (site)) & 1)) ? 2 : 1)
#ifndef PROBE_SUB
#define PROBE_SUB (-1)
#endif
#define SUBREPS(k) (PROBE_SUB == (k) ? 3 : 1)
struct SchedU { int G, c; DI bool next(int i, pg8::Unit& u) const { const long L = (long)i * G + c; if (L >= 512) return false; const int gi = (int)(L >> 7); u.grp = gi; u.pm = (int)(L & 127); u.pn = 0; u.kb = 0;
    u.aoff = (size_t)gi * ((size_t)32768 * 1024 * 2) + (size_t)u.pm * (256 * 1024 * 2); u.boff = (size_t)(gi >> 1) * WL_SIZE + (size_t)(gi & 1) * (256 * 1024 * 2); return true; } };
template <unsigned MASK> __global__ void __launch_bounds__(512, 2) mega(Params P) {
    extern __shared__ __attribute__((aligned(16))) unsigned char lds_raw[];
    LAS unsigned char* lds = (LAS unsigned char*)lds_raw;
    volatile LAS unsigned* MISC = (volatile LAS unsigned*)(lds + LDS_MISC);
    if (threadIdx.x < 64) MISC[threadIdx.x] = 0u;
    __syncthreads();
    XcdBarrier bar = xcd_barrier_post((unsigned*)(P.ws + WS_CTL) + 1024 + (size_t)P.li * XCD_BAR_WORDS, MISC + 8);
#define INW(k) (P.ph_lo <= (k) && (k) < P.ph_hi)
#define RUN(site, k) (((MASK >> (site)) & 1u) && INW(k))
#define SEAM(k) do { if (MASK == 0x7FFu && INW(k) && INW((k) + 1)) xcd_barrier(bar); } while (0)
    if (RUN(0, 0)) for (int rep_ = 0; rep_ < REPS(0); ++rep_) { if (rep_) xcd_barrier(bar); const Frame F = mk_frame(lds); phase_pa(P, F); }
    SEAM(0);
    if (RUN(1, 1)) for (int rep_ = 0; rep_ < REPS(1); ++rep_) { if (rep_) xcd_barrier(bar); const Frame F = mk_frame(lds);
        for (int it = F.gw; it < 4; it += F.ngw) { const float* cp = (const float*)(wl(P, it >> 1) + WL_CBP) + (it & 1) * 1024; float* cf = (float*)(wl(P, it >> 1) + WL_CBF) + (it & 1) * 128;
            float a0 = 0.f, a1 = 0.f;
#pragma unroll
            for (int q = 0; q < 8; ++q) { a0 += cp[q * 128 + F.lane]; a1 += cp[q * 128 + 64 + F.lane]; }
            cf[F.lane] = a0; cf[64 + F.lane] = a1; }
        { pg8::Gemm g{(const bf16_t*)(P.ws + WS_MEMB), (const bf16_t*)(P.ws + WS_W + WL_WMEM), 1024, 1024, 1024};
          pg8::SchedGroups S{4, 4, 2, F.G, F.G - 1 - F.cu, (size_t)256 * 1024 * 2, (size_t)256 * 1024 * 2, 0, WL_SIZE};
          EpiScaleF32 E{(float*)(P.ws + WS_MKVRAW), (size_t)1024 * 1024, 1024, (const float*)(P.ws + WS_RINVM)};
          pg8::gemm_phase(lds, g, S, E); }
        { volatile LAS int* qw = (volatile LAS int*)(lds + LDS_MISC + 64);
          unsigned* head = (unsigned*)(P.ws + WS_QUEUE) + 64 * rep_;
          for (;;) {
              __syncthreads();
              if (F.tid == 0) qw[0] = (int)__hip_atomic_fetch_add(head, 1u, __ATOMIC_RELAXED, __HIP_MEMORY_SCOPE_AGENT);
              __syncthreads();
              const int u = qw[0];
              if (u >= 1040) break;
              ugemm_unit(P, u / 260, u % 260, lds); } }
    }
    for (int l = 0; l < 2; ++l) {
        const int k0 = 2 + 9 * l;
        unsigned char* WL = wl(P, l);
        if (RUN(2, k0 + 0)) for (int rep_ = 0; rep_ < REPS(2); ++rep_) { if (rep_) xcd_barrier(bar); const Frame F = mk_frame(lds);
            pg8::Gemm g{(const bf16_t*)(P.ws + WS_XB), (const bf16_t*)(WL + WL_WIN), 1024, 1024, 1024};
            { LAS float* gt = (LAS float*)(lds + LDS_GT);
              for (int i = F.tid; i < 320; i += 512) gt[i] = i < 64 ? P.q_norm[l * 64 + i] : i < 128 ? P.k_norm[(l * 3 + 1) * 64 + i - 64] : i < 192 ? P.k_norm[(l * 3 + 2) * 64 + i - 128] : P.mem_q_norm[l * 128 + i - 192];
              __syncthreads(); }
            EpiInprojF E{(bf16_t*)(P.ws + WS_H), l == 0 ? (const float*)(P.ws + WS_RINV) : (const float*)(P.ws + WS_SSQ) + 2 * SSQ_STRIDE, (LAS float*)(lds + LDS_XS), (const LAS float*)(lds + LDS_GT), l,
                          (bf16_t*)(P.ws + WS_QC), (bf16_t*)(P.ws + WS_QR), (bf16_t*)(P.ws + WS_KS), (bf16_t*)(P.ws + WS_KW), (bf16_t*)(P.ws + WS_VST), (bf16_t*)(P.ws + WS_VWT), (bf16_t*)(P.ws + WS_MQ), P.out};
            if (F.G == 256) { pg8::SchedInprojBal S{F.cu, (size_t)256 * 1024 * 2, (size_t)256 * 1024 * 2}; pg8::gemm_phase(lds, g, S, E); }
            else { pg8::SchedMN S{64, 26, F.G, F.cu, (size_t)256 * 1024 * 2, (size_t)256 * 1024 * 2}; pg8::gemm_phase(lds, g, S, E); }
            if (2 * F.cu >= F.G) {
                for (int it = F.G - 1 - F.cu; it < 208; it += F.G / 2) s_inproj_item(P, l, it, lds);
                if (l == 0) { const Frame F2 = mk_frame(lds); LAS float* scr = (LAS float*)(lds + F2.wave * 16384); __syncthreads();
                    for (int it = (F2.G - 1 - F2.cu) * 8 + F2.wave; it < WI_LATE / 4; it += (F2.G / 2) * 8) weight_item(P, 1, it, scr, F2.lane); }
            }
        }
        SEAM(k0 + 0);
        if (RUN(3, k0 + 1)) for (int rep_ = 0; rep_ < REPS(3); ++rep_) { if (rep_) xcd_barrier(bar); const Frame F = mk_frame(lds);
            for (int it = F.gw; it < 1024; it += F.ngw) cmpu_wave(P, l, it, F.lane);
            { const Frame F2 = mk_frame(lds); LAS bf16_t* vt = (LAS bf16_t*)(lds + 65536 + F2.wave * 4096);
              for (int sr_ = 0; sr_ < SUBREPS(1); ++sr_) for (int blk = F2.gw; blk < MP / 8; blk += F2.ngw) post_conv8(P, l, 8 * blk, F2.lane); (void)vt; }
            { const Frame F2 = mk_frame(lds); for (int m = MP + (F2.ngw - 1 - F2.gw); m < MP + MS; m += F2.ngw) post_row(P, l, m, F2.lane); }
            { const Frame F2 = mk_frame(lds); for (int blk = F2.ngw - 1 - F2.gw; blk < 2336; blk += F2.ngw) wincopy_rows(P, l, blk, F2.lane); }
            if (l == 0) {
                { const Frame F2 = mk_frame(lds); for (int it = F2.gw; it < 2048; it += F2.ngw) memkv_row(P, it, F2.lane); }
            }
        }
        SEAM(k0 + 1);
        if (RUN(4, k0 + 2)) for (int rep_ = 0; rep_ < REPS(4); ++rep_) { if (rep_) xcd_barrier(bar); const Frame F = mk_frame(lds);
            for (int it = F.gw; it < 256; it += F.ngw) cmpp_task(P, l, it, F.lane);
            {
              const int q = F.G / 4, cls = F.cu / q, r = F.cu - cls * q;
              if (cls < 3 && F.cu < 256) mem_unit(P, l, F.cu >> 6, (F.cu >> 4) & 3, F.cu & 15, lds);
              if (cls == 0) for (int u = 3 * q + r; u < 256; u += q) mem_unit(P, l, u >> 6, (u >> 4) & 3, u & 15, lds);
              if (cls == 1) { for (int s = r; s < 64; s += q) sample_win_unit(P, l, s >> 1, s & 1, lds); for (int s = r; s < 64; s += q) sample_mem_unit(P, l, s >> 2, s & 3, lds); }
              if (cls == 2) for (int s = 64 + r; s < 128; s += q) sample_mem_unit(P, l, s >> 2, s & 3, lds);
              if (cls >= 3) for (int s = F.cu - 3 * q; s < 64; s += F.G - 3 * q) sample_nsa_unit(P, l, s >> 1, s & 1, lds); }
        }
        SEAM(k0 + 2);
        if (RUN(5, k0 + 3)) for (int rep_ = 0; rep_ < REPS(5); ++rep_) { if (rep_) xcd_barrier(bar); const Frame F = mk_frame(lds);
            for (int u = F.cu; u < 512; u += F.G) { const int r = u & 255, bg = r & 7, s = r >> 3, qb = (u < 256) ? 63 - s : s;
                const unsigned long long sel = cmp_unit(P, bg >> 1, bg & 1, qb, lds);
                nsa_unit(P, l, bg >> 1, bg & 1, qb, lds, sel); }
            { const Frame F2 = mk_frame(lds); for (int b = F2.gw; b < 32; b += F2.ngw) sample_combine_row(P, b, F2.lane); }
        }
        SEAM(k0 + 3);
        if (RUN(7, k0 + 5)) for (int rep_ = 0; rep_ < REPS(7); ++rep_) { if (rep_) xcd_barrier(bar); const Frame F = mk_frame(lds);
            pg8::Gemm g{(const bf16_t*)(P.ws + WS_BR), (const bf16_t*)(WL + WL_WBR), 1536, 1536, 512};
            pg8::SchedBranch S{64, 4, F.G, F.cu, (size_t)256 * 1536 * 2, (size_t)256 * 1536 * 2};
            EpiBranch E{(bf16_t*)(P.ws + WS_MG), (const bf16_t*)(P.ws + WS_H)};
            pg8::gemm_phase(lds, g, S, E);
            for (int it = F.G - 1 - F.cu; it < 32; it += F.G) s_branch_item(P, l, it, lds);
        }
        SEAM(k0 + 5);
        if (RUN(8, k0 + 6)) for (int rep_ = 0; rep_ < REPS(8); ++rep_) { if (rep_) xcd_barrier(bar); const Frame F = mk_frame(lds);
            pg8::Gemm g{(const bf16_t*)(P.ws + WS_MG), (const bf16_t*)(WL + WL_WOUT), 1024, 1024, 1024};
            pg8::SchedMN S{64, 4, F.G, F.cu, (size_t)256 * 1024 * 2, (size_t)256 * 1024 * 2};
            EpiResidual E{l == 0 ? P.x_prompt : (const float*)(P.ws + WS_XNEXT), (float*)(P.ws + WS_HRES), rep_ ? (bf16_t*)nullptr : (bf16_t*)(P.ws + WS_HB), (float*)(P.ws + WS_SSQ) + (size_t)l * SSQ_STRIDE};
            pg8::gemm_phase(lds, g, S, E);
            if (rep_ == 0) for (int it = F.G - 1 - F.cu; it < 32; it += F.G) s_wout_item(P, l, it, lds);
        }
        SEAM(k0 + 6);
        if (RUN(9, k0 + 7)) for (int rep_ = 0; rep_ < REPS(9); ++rep_) { if (rep_) xcd_barrier(bar); const Frame F = mk_frame(lds);
            pg8::Gemm g{(const bf16_t*)(P.ws + WS_HB), (const bf16_t*)(WL + WL_WGU), 1024, 1024, 1024};
            pg8::SchedMN S{64, 22, F.G, F.cu, (size_t)256 * 1024 * 2, (size_t)256 * 1024 * 2};
            EpiGateUp E{(bf16_t*)(P.ws + WS_ACT), (const float*)(P.ws + WS_SSQ) + (size_t)l * SSQ_STRIDE};
            pg8::gemm_phase(lds, g, S, E);
            if (2 * F.cu >= F.G) {
                for (int it = F.G - 1 - F.cu; it < 176; it += F.G / 2) s_gateup_item(P, l, it, lds);
                if (l == 0) { const Frame F2 = mk_frame(lds); LAS float* scr = (LAS float*)(lds + F2.wave * 16384); __syncthreads();
                    for (int it = WI_LATE / 4 + (F2.G - 1 - F2.cu) * 8 + F2.wave; it < WI_LATE; it += (F2.G / 2) * 8) weight_item(P, 1, it, scr, F2.lane); }
            }
        }
        SEAM(k0 + 7);
        if (RUN(10, k0 + 8)) for (int rep_ = 0; rep_ < REPS(10); ++rep_) { if (rep_) xcd_barrier(bar); const Frame F = mk_frame(lds);
            pg8::Gemm g{(const bf16_t*)(P.ws + WS_ACT), (const bf16_t*)(WL + WL_WDN), D_FF, D_FF, D_FF};
            pg8::SchedMN S{64, 4, F.G, F.cu, (size_t)256 * D_FF * 2, (size_t)256 * D_FF * 2};
            EpiResidual E{(const float*)(P.ws + WS_HRES), l == 0 ? (float*)(P.ws + WS_XNEXT) : P.out + O_Y, (l == 0 && rep_ == 0) ? (bf16_t*)(P.ws + WS_XB) : (bf16_t*)nullptr, (float*)(P.ws + WS_SSQ) + 2 * SSQ_STRIDE};
            pg8::gemm_phase(lds, g, S, E);
            if (rep_ == 0) for (int it = F.G - 1 - F.cu; it < 32; it += F.G) s_down_item(P, l, it, lds);
        }
        if (l == 0) SEAM(k0 + 8);
    }
#if defined(PROBE_BARRIERS)
    for (int i_ = 0; i_ < PROBE_BARRIERS; ++i_) xcd_barrier(bar);
#endif
#undef RUN
#undef INW
#undef SEAM
}

extern "C" void kernel_launch(void* const* d_in, const int* in_sizes, int n_in, void* d_out, int out_size, void* d_ws, size_t ws_size, hipStream_t stream) {
    static int grid = 0;
    if (grid == 0) {
        if (n_in != 25 || (size_t)out_size != O_TOTAL || ws_size < WS_END) { fprintf(stderr, "kernel_launch: unexpected shapes (n_in %d, out %d, ws %zu < %zu)\n", n_in, out_size, ws_size, (size_t)WS_END); grid = -1; return; }
        int dev = 0, cus = 0, per_cu = 0;
        if (hipGetDevice(&dev) != hipSuccess || hipDeviceGetAttribute(&cus, hipDeviceAttributeMultiprocessorCount, dev) != hipSuccess) { grid = -1; return; }
#if N_LAUNCH_MODE == 0
        if (hipFuncSetAttribute((const void*)mega<0x7FFu>, hipFuncAttributeMaxDynamicSharedMemorySize, LDS_BYTES) != hipSuccess) { fprintf(stderr, "kernel_launch: hipFuncSetAttribute failed\n"); grid = -1; return; }
        if (hipOccupancyMaxActiveBlocksPerMultiprocessor(&per_cu, (const void*)mega<0x7FFu>, 512, LDS_BYTES) != hipSuccess || per_cu < 1) fprintf(stderr, "kernel_launch: occupancy query says %d\n", per_cu);
#else
#define LATTR(s) if (hipFuncSetAttribute((const void*)mega<(1u << s)>, hipFuncAttributeMaxDynamicSharedMemorySize, LDS_BYTES) != hipSuccess) { fprintf(stderr, "kernel_launch: hipFuncSetAttribute failed\n"); grid = -1; return; }
        LATTR(0) LATTR(1) LATTR(2) LATTR(3) LATTR(4) LATTR(5) LATTR(6) LATTR(7) LATTR(8) LATTR(9) LATTR(10)
#undef LATTR
        per_cu = 1;
#endif
        (void)hipGetLastError();
        grid = cus;
    }
    if (grid < 0) return;
    (void)hipMemsetAsync((char*)d_ws + WS_CTL, 0, CTL_BYTES, stream);
    Params p{};
    p.x_prompt = (const float*)d_in[0]; p.x_sample = (const float*)d_in[1]; p.cache_nsa = (const float*)d_in[2]; p.cache_win = (const float*)d_in[3];
    p.state_conv = (const float*)d_in[4]; p.cache_mem = (const float*)d_in[5]; p.page_table = (const int*)d_in[6]; p.mem_prompt = (const float*)d_in[7];
    p.norm_mix = (const float*)d_in[8]; p.w_in = (const float*)d_in[9]; p.q_norm = (const float*)d_in[10]; p.k_norm = (const float*)d_in[11];
    p.cmp_pe = (const float*)d_in[12]; p.cmp_w1 = (const float*)d_in[13]; p.cmp_w2 = (const float*)d_in[14]; p.conv_w = (const float*)d_in[15];
    p.norm_mem = (const float*)d_in[16]; p.w_mem_kv = (const float*)d_in[17]; p.mem_q_norm = (const float*)d_in[18]; p.mem_k_norm = (const float*)d_in[19];
    p.w_branch = (const float*)d_in[20]; p.w_out = (const float*)d_in[21]; p.norm_ffn = (const float*)d_in[22]; p.w_gate_up = (const float*)d_in[23]; p.w_down = (const float*)d_in[24];
    p.out = (float*)d_out; p.ws = (unsigned char*)d_ws;
#if N_LAUNCH_MODE == 0
    p.ph_lo = 0; p.ph_hi = NPHASE; p.li = 0; p.pad = 0;
    hipLaunchKernelGGL(mega<0x7FFu>, dim3(grid), dim3(512), LDS_BYTES, stream, p);
#else
    for (int k = 0; k < NPHASE; ++k) { p.ph_lo = k; p.ph_hi = k + 1; p.li = k; p.pad = 0; const int site = k < 2 ? k : 2 + (k - 2) % 9;
        switch (site) {
#define LCASE(s) case s: hipLaunchKernelGGL(mega<(1u << s)>, dim3(grid), dim3(512), LDS_BYTES, stream, p); break;
            LCASE(0) LCASE(1) LCASE(2) LCASE(3) LCASE(4) LCASE(5) LCASE(6) LCASE(7) LCASE(8) LCASE(9) LCASE(10)
#undef LCASE
        } }
#endif
    if (hipPeekAtLastError() != hipSuccess) fprintf(stderr, "kernel_launch: launch failed: %s\n", hipGetErrorName(hipGetLastError()));
}
```

```cpp
#include <hip/hip_runtime.h>
#include <cstdio>
#include <cstdint>
#include <cmath>

#define LAS __attribute__((address_space(3)))
#define GAS __attribute__((address_space(1)))
#define DI __device__ __forceinline__

typedef unsigned short bf16_t;
typedef short bf16x8 __attribute__((ext_vector_type(8)));
typedef short s16x4 __attribute__((ext_vector_type(4)));
typedef float f32x4 __attribute__((ext_vector_type(4)));
typedef float f32x2 __attribute__((ext_vector_type(2)));
typedef float f32x16 __attribute__((ext_vector_type(16)));
typedef unsigned u32x4 __attribute__((ext_vector_type(4)));
typedef unsigned u32x2 __attribute__((ext_vector_type(2)));

constexpr int D_MODEL = 1024, BATCH = 4, SEQ = 4096, DEPTH = 2, DEC_B = 32, PAST = 8192, PAGE = 128;
constexpr int HD = 64, BW = 512, NH = 8, NKV = 2, GRP = 4;
constexpr int NPAGES = PAST / PAGE;
constexpr int NPHYS = 2560;
constexpr int MP = BATCH * SEQ;
constexpr int MS = DEC_B;
constexpr int MR = MP + 256;
constexpr int D_FF = 2816;
constexpr int N_IN = 6424;
constexpr int LDH = 6656;
constexpr int HQ = 0, HKV = 512, HCX = 1280, HCB = 1792, HCC = 2304, HMQ = 2816, HMG = 3328, HNG = 6400;
constexpr int SIG_TILE = 13;
constexpr float EPS = 1e-6f;
constexpr float LOG2E = 1.4426950408889634f;
constexpr float C2 = 0.125f * LOG2E;
constexpr float C2M = 0.08838834764831845f * LOG2E;

constexpr size_t O_Y = 0, O_YS = 16777216, O_ROWS = 16809984, O_ROWSS = 33587200, O_WIN = 33619968, O_WINS = 34668544,
                 O_CONV = 43057152, O_CONVS = 43065344, O_MKV = 43130880, O_TOTAL = 45228032;

constexpr size_t al4k(size_t x) { return (x + 4095) & ~(size_t)4095; }
constexpr size_t WS_CTL = 0, CTL_BYTES = 1u << 20;
constexpr size_t WS_SSQ = WS_CTL + 524288;
constexpr size_t SSQ_STRIDE = (size_t)(16384 + 256);
constexpr size_t WS_QUEUE = WS_CTL + 409600;
constexpr size_t WL_WIN = 0;
constexpr size_t WL_WBR = WL_WIN + al4k((size_t)LDH * 1024 * 2);
constexpr size_t WL_WOUT = WL_WBR + al4k((size_t)1024 * 1536 * 2);
constexpr size_t WL_WGU = WL_WOUT + al4k((size_t)1024 * 1024 * 2);
constexpr size_t WL_WDN = WL_WGU + al4k((size_t)5632 * 1024 * 2);
constexpr size_t WL_WMEM = WL_WDN + al4k((size_t)1024 * 2816 * 2);
constexpr size_t WL_W1C = WL_WMEM + al4k((size_t)1024 * 1024 * 2);
constexpr size_t WL_W2T = WL_W1C + al4k((size_t)2 * 256 * 1024 * 2);
constexpr size_t WL_CBP = WL_W2T + al4k((size_t)2 * 64 * 128 * 2);
constexpr size_t WL_CBF = WL_CBP + al4k((size_t)2 * 8 * 128 * 4);
constexpr size_t WL_SIZE = WL_CBF + al4k((size_t)2 * 128 * 4);
constexpr size_t WS_W = WS_CTL + CTL_BYTES;
constexpr size_t WS_XB = WS_W + 2 * WL_SIZE;
constexpr size_t WS_RINV = WS_XB + al4k((size_t)MR * 1024 * 2);
constexpr size_t WS_H = WS_RINV + al4k((size_t)MR * 4);
constexpr size_t WS_QC = WS_H + al4k((size_t)MR * LDH * 2);
constexpr size_t WS_QR = WS_QC + al4k((size_t)MR * 512 * 2);
constexpr size_t WS_KS = WS_QR + al4k((size_t)MR * 512 * 2);
constexpr size_t WS_VST = WS_KS + al4k((size_t)MP * 128 * 2);
constexpr size_t WS_KW = WS_VST + al4k((size_t)MP * 128 * 2);
constexpr size_t WS_VWT = WS_KW + al4k((size_t)MP * 128 * 2);
constexpr size_t WS_KC = WS_VWT + al4k((size_t)MP * 128 * 2);
constexpr size_t WS_VCT = WS_KC + al4k((size_t)8 * 256 * 64 * 2);
constexpr size_t WS_UP = WS_VCT + al4k((size_t)8 * 256 * 64 * 2);
constexpr size_t WS_OC = WS_UP + al4k((size_t)2 * 2048 * 256 * 2);
constexpr size_t WS_SEL = WS_OC + al4k((size_t)MR * 512 * 2);
constexpr size_t WS_BR = WS_SEL + al4k((size_t)MP * 2 * 8);
constexpr size_t WS_MQ = WS_BR + al4k((size_t)MR * 1536 * 2);
constexpr size_t WS_MG = WS_MQ + al4k((size_t)MR * 512 * 2);
constexpr size_t WS_HRES = WS_MG + al4k((size_t)MR * 1024 * 2);
constexpr size_t WS_HB = WS_HRES + al4k((size_t)MR * 1024 * 4);
constexpr size_t WS_RINV2 = WS_HB + al4k((size_t)MR * 1024 * 2);
constexpr size_t WS_ACT = WS_RINV2 + al4k((size_t)MR * 4);
constexpr size_t WS_XNEXT = WS_ACT + al4k((size_t)MR * D_FF * 2);
constexpr size_t WS_AC = WS_XNEXT + al4k((size_t)MR * 1024 * 4);
constexpr size_t WS_US = WS_AC + al4k((size_t)4 * 32768 * 1024 * 2);
constexpr size_t WS_KCS = WS_US + al4k((size_t)4 * 32768 * 256 * 2);
constexpr size_t WS_VCS = WS_KCS + al4k((size_t)2 * 32 * 2 * 512 * 64 * 4);
constexpr size_t WS_MEMB = WS_VCS + al4k((size_t)2 * 32 * 2 * 512 * 64 * 4);
constexpr size_t WS_RINVM = WS_MEMB + al4k((size_t)1024 * 1024 * 2);
constexpr size_t WS_MKVRAW = WS_RINVM + al4k((size_t)1024 * 4);
constexpr size_t WS_MK = WS_MKVRAW + al4k((size_t)2 * 1024 * 1024 * 4);
constexpr size_t WS_MVT = WS_MK + al4k((size_t)2 * 16 * 256 * 128 * 2);
constexpr size_t WS_SOUT = WS_MVT + al4k((size_t)2 * 16 * 256 * 128 * 2);
constexpr size_t WS_END = WS_SOUT + al4k((size_t)32 * 1536 * 4);

constexpr int LDS_MAIN = 131072;
constexpr int LDS_MISC = LDS_MAIN;
constexpr int LDS_GT = LDS_MAIN + 256;
constexpr int LDS_XS = LDS_MAIN + 2048;
constexpr int LDS_BYTES = 147456;

DI unsigned f2bf(float f) { unsigned u = __builtin_bit_cast(unsigned, f); return (u + 0x7fffu + ((u >> 16) & 1u)) >> 16; }
typedef __bf16 bf16x2_t __attribute__((ext_vector_type(2)));
DI unsigned pk2(float lo, float hi) { const f32x2 v = {lo, hi}; return __builtin_bit_cast(unsigned, __builtin_convertvector(v, bf16x2_t)); }
DI float bflo(unsigned w) { return __builtin_bit_cast(float, w << 16); }
DI float bfhi(unsigned w) { return __builtin_bit_cast(float, w & 0xffff0000u); }
DI float bf2f(bf16_t v) { return __builtin_bit_cast(float, (unsigned)v << 16); }
DI float fexp2(float x) { return __builtin_amdgcn_exp2f(x); }
DI float frcp(float x) { return __builtin_amdgcn_rcpf(x); }
DI float sigmoidf_(float v) { return frcp(1.0f + fexp2(-v * LOG2E)); }
DI float wave_sum(float v) {
#pragma unroll
    for (int o = 1; o < 64; o <<= 1) v += __shfl_xor(v, o);
    return v;
}
DI void unpack8(u32x4 w, float (&f)[8]) {
    f[0] = bflo(w.x); f[1] = bfhi(w.x); f[2] = bflo(w.y); f[3] = bfhi(w.y); f[4] = bflo(w.z); f[5] = bfhi(w.z); f[6] = bflo(w.w); f[7] = bfhi(w.w);
}
DI u32x4 pack8(const float (&f)[8]) { u32x4 w; w.x = pk2(f[0], f[1]); w.y = pk2(f[2], f[3]); w.z = pk2(f[4], f[5]); w.w = pk2(f[6], f[7]); return w; }
#define LDS_WAIT() asm volatile("s_waitcnt lgkmcnt(0)" ::: "memory")
#define VM_WAIT() asm volatile("s_waitcnt vmcnt(0)" ::: "memory")
#define MFMA32(a, b, c) __builtin_amdgcn_mfma_f32_32x32x16_bf16((a), (b), (c), 0, 0, 0)
#define MFMA16(a, b, c) __builtin_amdgcn_mfma_f32_16x16x32_bf16((a), (b), (c), 0, 0, 0)
DI int ltid() { int t = threadIdx.x; asm volatile("" : "+v"(t)); return t; }
DI int crow(int r, int hi) { return (r & 3) + 8 * (r >> 2) + 4 * hi; }

struct Params {
    const float* x_prompt; const float* x_sample; const float* cache_nsa; const float* cache_win; const float* state_conv; const float* cache_mem;
    const int* page_table; const float* mem_prompt; const float* norm_mix; const float* w_in; const float* q_norm; const float* k_norm;
    const float* cmp_pe; const float* cmp_w1; const float* cmp_w2; const float* conv_w; const float* norm_mem; const float* w_mem_kv;
    const float* mem_q_norm; const float* mem_k_norm; const float* w_branch; const float* w_out; const float* norm_ffn; const float* w_gate_up; const float* w_down;
    float* out; unsigned char* ws;
    int ph_lo, ph_hi, li, pad;
};
namespace pg8 {
constexpr int BM = 256, BK = 64, HALF = 128, HTB = HALF * BK * 2  , STAGE_BYTES = 8 * HTB, NXCD = 8, WGM = 2;

__host__ __device__ __forceinline__ int lds_byte(int r, int c) { const int st = (r >> 4) * 2 + (c >> 5), rr = r & 15, cc = c & 31, ob = rr * 64 + cc * 2; return st * 1024 + (ob ^ (((ob >> 9) & 1) << 5)); }
__host__ __device__ __forceinline__ void stage_rc(int b, int& R, int& C) { const int st = b / 1024, sb = b % 1024, swz = sb ^ (((sb >> 9) & 1) << 5); R = (st >> 1) * 16 + swz / 64; C = (st & 1) * 32 + (swz % 64) / 2; }
__host__ __device__ __forceinline__ int perm32(int rho) { const int n = rho >> 4, i = rho & 15; return 8 * (i >> 2) + 4 * n + (i & 3); }

struct Unit { int pm, pn, kb, grp; size_t aoff, boff; };
struct Gemm { const bf16_t* A; const bf16_t* Bt; int lda, ldb, K; };

DI bool static_tile(int i, int G, int c, int nM, int nN, int& pm, int& pn) {
    const int nwg = nM * nN; const long L = (long)i * G + c; if (L >= nwg) return false;
    int wgid = (int)L; { const int q = nwg / NXCD, r = nwg % NXCD, xcd = wgid % NXCD, off = wgid / NXCD; wgid = (xcd < r ? xcd * (q + 1) : r * (q + 1) + (xcd - r) * q) + off; }
    const int nig = WGM * nN, gid = wgid / nig, fm = gid * WGM, gsz = (nM - fm) < WGM ? (nM - fm) : WGM;
    pm = fm + ((wgid % nig) % gsz); pn = (wgid % nig) / gsz; return true;
}
struct SchedMN {
    int nM, nN, G, c; size_t ta, tb;
    DI bool next(int i, Unit& u) const { if (!static_tile(i, G, c, nM, nN, u.pm, u.pn)) return false; u.kb = 0; u.grp = 0; u.aoff = (size_t)u.pm * ta; u.boff = (size_t)u.pn * tb; return true; }
};
struct SchedInprojBal {
    int c; size_t ta, tb;
    DI static bool fusedcol(int pn) { return pn <= 1 || pn == 3 || pn == 4 || pn == 11 || pn == 12; }
    DI bool next(int i, Unit& u) const {
        const int cl = c & 127; const bool heavy = c < 128; int pmA, pnA, pmB, pnB;
        if (!static_tile(i, 256, cl, 64, 26, pmA, pnA)) return false;
        int pm = pmA, pn = pnA;
        if (static_tile(i, 256, cl + 128, 64, 26, pmB, pnB)) { const bool swap = fusedcol(pnA) && !fusedcol(pnB); if (heavy == swap) { pm = pmB; pn = pnB; } }
        else if (!heavy) return false;
        u.pm = pm; u.pn = pn; u.kb = 0; u.grp = 0; u.aoff = (size_t)pm * ta; u.boff = (size_t)pn * tb; return true; }
};
struct SchedBranch {
    int nM, nN, G, c; size_t ta, tb;
    DI bool next(int i, Unit& u) const { if (!static_tile(i / 3, G, c, nM, nN, u.pm, u.pn)) return false; u.kb = i % 3; u.grp = 0;
        u.aoff = (size_t)u.pm * ta + (size_t)u.kb * 1024; u.boff = (size_t)u.pn * tb + (size_t)u.kb * 1024; return true; }
};
struct SchedGroups {
    int nM, nN, ngrp, G, c; size_t ta, tb, ga, gb;
    DI bool next(int i, Unit& u) const { const long L = (long)i * G + c; const int per = nM * nN; if (L >= (long)per * ngrp) return false;
        const int gi = (int)(L / per), r = (int)(L % per); u.grp = gi; u.pm = r / nN; u.pn = r % nN; u.kb = 0;
        u.aoff = (size_t)gi * ga + (size_t)u.pm * ta; u.boff = (size_t)gi * gb + (size_t)u.pn * tb; return true; }
};

template <class Epi, class Sched>
DI void gemm_phase(LAS unsigned char* lds, const Gemm g, const Sched& S, const Epi& E) {
    const int tid = ltid(), wid = __builtin_amdgcn_readfirstlane(tid >> 6), lane = tid & 63, wr = wid >> 2, wc = wid & 3, fr = lane & 15, fq = lane >> 4;
    const int nt = g.K / BK;
    unsigned voffA[2], voffB[2];
#pragma unroll
    for (int i = 0; i < 2; ++i) { int R, C; stage_rc(tid * 16 + i * 8192, R, C); const int Rb = Epi::PERM ? ((R & ~31) + perm32(R & 31)) : R;
        voffA[i] = (unsigned)(R * g.lda + C) * 2u; voffB[i] = (unsigned)(Rb * g.ldb + C) * 2u; }
    const size_t kstep = (size_t)(BK * 2);
    const size_t hstepA = (size_t)HALF * g.lda * 2, hstepB = (size_t)HALF * g.ldb * 2;
    const unsigned ldsw = (unsigned)wid * 1024u;
    const int aoff = lds_byte(wr * 64 + fr, fq * 8), boff = lds_byte(wc * 32 + fr, fq * 8);
#define PG8_SA(b, h) (((b) * 2 + (h)) * HTB)
#define PG8_SB(b, h) ((4 + (b) * 2 + (h)) * HTB)
#define PG8_STAGE(bufoff, gbase, voff) do { _Pragma("unroll") for (int _i = 0; _i < 2; ++_i) \
        __builtin_amdgcn_global_load_lds((const unsigned*)((const char*)(gbase) + (voff)[_i]), (LAS unsigned*)(lds + (bufoff) + ldsw + _i * 8192), 16, 0, 0); } while (0)
#define PG8_LDA(dst, b, h) do { _Pragma("unroll") for (int m = 0; m < 4; ++m) _Pragma("unroll") for (int k = 0; k < 2; ++k) dst[m][k] = *(const LAS bf16x8*)(lds + PG8_SA(b, h) + aoff + m * 2048 + k * 1024); } while (0)
#define PG8_LDB(dst, b, h) do { _Pragma("unroll") for (int n = 0; n < 2; ++n) _Pragma("unroll") for (int k = 0; k < 2; ++k) dst[n][k] = *(const LAS bf16x8*)(lds + PG8_SB(b, h) + boff + n * 2048 + k * 1024); } while (0)
#define PG8_MMA(ai, bj, At, Bt) do { __builtin_amdgcn_s_setprio(1); _Pragma("unroll") for (int m = 0; m < 4; ++m) _Pragma("unroll") for (int n = 0; n < 2; ++n) _Pragma("unroll") for (int k = 0; k < 2; ++k) \
        acc[ai][bj][m][n] = __builtin_amdgcn_mfma_f32_16x16x32_bf16(Bt[n][k], At[m][k], acc[ai][bj][m][n], 0, 0, 0); __builtin_amdgcn_s_setprio(0); } while (0)
#define PG8_WAIT_V(n) asm volatile("s_waitcnt vmcnt(" #n ")" ::: "memory")
#define PG8_WAIT_L(n) asm volatile("s_waitcnt lgkmcnt(" #n ")" ::: "memory")
#define PG8_BAR __builtin_amdgcn_s_barrier()
#define PG8_SCHED __builtin_amdgcn_sched_barrier(0)
    Unit cur, nxt; int ui = 0;
    if (!S.next(0, cur)) return;
    f32x4 acc[2][2][4][2];
#pragma unroll
    for (int a = 0; a < 2; ++a)
#pragma unroll
        for (int b = 0; b < 2; ++b)
#pragma unroll
            for (int m = 0; m < 4; ++m)
#pragma unroll
                for (int n = 0; n < 2; ++n) acc[a][b][m][n] = (f32x4){0.f, 0.f, 0.f, 0.f};
    bf16x8 At[4][2], B0[2][2], B1[2][2];
    const char* cA = (const char*)g.A + cur.aoff; const char* cB = (const char*)g.Bt + cur.boff;
    PG8_STAGE(PG8_SB(0, 0), cB, voffB); PG8_STAGE(PG8_SB(0, 1), cB + hstepB, voffB); PG8_STAGE(PG8_SA(0, 0), cA, voffA); PG8_STAGE(PG8_SA(0, 1), cA + hstepA, voffA);
    if (wr == 1) PG8_BAR;
    PG8_WAIT_V(2); PG8_BAR;
    PG8_STAGE(PG8_SB(1, 0), cB + kstep, voffB); PG8_STAGE(PG8_SA(1, 0), cA + kstep, voffA); PG8_STAGE(PG8_SB(1, 1), cB + hstepB + kstep, voffB);
    PG8_WAIT_V(6); PG8_BAR;
    for (;;) {
        const bool has_next = S.next(ui + 1, nxt);
        const char* nA = has_next ? (const char*)g.A + nxt.aoff : cA; const char* nB = has_next ? (const char*)g.Bt + nxt.boff : cB;
        for (int t = 0; t < nt; t += 2) {
            const bool last = (t == nt - 2);
            const char* a1 = cA + (size_t)(t + 1) * kstep;
            const char* a2 = last ? nA : cA + (size_t)(t + 2) * kstep; const char* b2 = last ? nB : cB + (size_t)(t + 2) * kstep;
            const char* a3 = a2 + kstep; const char* b3 = b2 + kstep;
            PG8_LDB(B0, 0, 0); PG8_LDB(B1, 0, 1); PG8_SCHED; PG8_LDA(At, 0, 0); PG8_STAGE(PG8_SA(1, 1), a1 + hstepA, voffA);
            PG8_WAIT_V(8); PG8_WAIT_L(0); PG8_BAR; PG8_MMA(0, 0, At, B0); PG8_MMA(0, 1, At, B1); PG8_BAR; PG8_SCHED;
            PG8_LDA(At, 0, 1); PG8_STAGE(PG8_SB(0, 0), b2, voffB); PG8_STAGE(PG8_SB(0, 1), b2 + hstepB, voffB); PG8_STAGE(PG8_SA(0, 0), a2, voffA);
            PG8_WAIT_V(8); PG8_WAIT_L(0); PG8_BAR; PG8_MMA(1, 0, At, B0); PG8_MMA(1, 1, At, B1); PG8_BAR; PG8_SCHED;
            PG8_LDB(B0, 1, 0); PG8_LDB(B1, 1, 1); PG8_SCHED; PG8_LDA(At, 1, 0); PG8_STAGE(PG8_SA(0, 1), a2 + hstepA, voffA);
            PG8_WAIT_V(8); PG8_WAIT_L(0); PG8_BAR; PG8_MMA(0, 0, At, B0); PG8_MMA(0, 1, At, B1); PG8_BAR; PG8_SCHED;
            PG8_LDA(At, 1, 1); PG8_STAGE(PG8_SB(1, 0), b3, voffB); PG8_STAGE(PG8_SB(1, 1), b3 + hstepB, voffB); PG8_STAGE(PG8_SA(1, 0), a3, voffA);
            PG8_WAIT_V(8); PG8_WAIT_L(0); PG8_BAR; PG8_MMA(1, 0, At, B0); PG8_MMA(1, 1, At, B1); PG8_BAR; PG8_SCHED;
        }
        if (wr == 0) PG8_BAR;
        E(acc, cur, wr, wc, fr, fq);
        if (!has_next) break;
        if (!(Epi::CARRY && cur.kb < 2)) {
#pragma unroll
        for (int a = 0; a < 2; ++a)
#pragma unroll
            for (int b = 0; b < 2; ++b)
#pragma unroll
                for (int m = 0; m < 4; ++m)
#pragma unroll
                    for (int n = 0; n < 2; ++n) acc[a][b][m][n] = (f32x4){0.f, 0.f, 0.f, 0.f};
        }
        cur = nxt; cA = nA; cB = nB; ++ui;
        if (wr == 1) PG8_BAR;
    }
    PG8_WAIT_V(0);
    PG8_BAR;
#undef PG8_SA
#undef PG8_SB
#undef PG8_STAGE
#undef PG8_LDA
#undef PG8_LDB
#undef PG8_MMA
#undef PG8_WAIT_V
#undef PG8_WAIT_L
#undef PG8_BAR
#undef PG8_SCHED
}
}
#define XB_TMO      128
#define XB_XCNT(j)  (256  + 64 * (j))
#define XB_XSUB(j)  (1280 + 64 * (j))
#define XB_XGEN(j)  (2304 + 64 * (j))
#define XB_TOP      3328
#define XB_TOPGEN   3392
#define XCD_BAR_WORDS 3456
#define XB_SPIN_CAP (1u << 18)

__device__ __forceinline__ unsigned xb_ld(unsigned* p)              { return __hip_atomic_load(p, __ATOMIC_RELAXED, __HIP_MEMORY_SCOPE_AGENT); }
__device__ __forceinline__ unsigned xb_add(unsigned* p, unsigned v) { return __hip_atomic_fetch_add(p, v, __ATOMIC_RELAXED, __HIP_MEMORY_SCOPE_AGENT); }
__device__ __forceinline__ unsigned xb_xcc_id() { return (unsigned)__builtin_amdgcn_s_getreg((3 << 11) | 20) & 0xFu; }
#define XB_SPIN(cond, bar) do { unsigned _sp = 0; while (cond) { __builtin_amdgcn_s_sleep(1); \
    if ((++_sp & 255u) == 0u) { if (xb_ld(&(bar)[XB_TMO])) break; if (_sp > XB_SPIN_CAP) { atomicAdd(&(bar)[XB_TMO], 1u); break; } } } } while (0)

struct XcdBarrier {
    unsigned* bar; unsigned x;
    volatile LAS unsigned* st;
};

__device__ __forceinline__ XcdBarrier xcd_barrier_post(unsigned* bar, volatile LAS unsigned* st) {
    XcdBarrier b; b.bar = bar; b.x = xb_xcc_id(); b.st = st;
    if (threadIdx.x == 0) (void)xb_add(&bar[XB_XCNT(b.x)], 1u);
    return b;
}
__device__ __forceinline__ void xcd_barrier_complete(unsigned* bar, unsigned x, unsigned& nloc, unsigned& nx) {
    const unsigned G = gridDim.x * gridDim.y * gridDim.z;
    unsigned sum, cnt, mine, sp = 0u;
    for (;;) {
        sum = 0u; cnt = 0u; mine = 0u;
#pragma unroll
        for (unsigned j = 0; j < 16; ++j) { const unsigned c = xb_ld(&bar[XB_XCNT(j)]); sum += c; cnt += (c > 0u) ? 1u : 0u; mine = (j == x) ? c : mine; }
        if (sum == G) break;
        __builtin_amdgcn_s_sleep(1);
        if ((++sp & 255u) == 0u) { if (xb_ld(&bar[XB_TMO])) break; if (sp > XB_SPIN_CAP) { atomicAdd(&bar[XB_TMO], 1u); break; } }
    }
    nloc = mine > 0u ? mine : 1u; nx = cnt > 0u ? cnt : 1u;
}

__device__ __forceinline__ void xcd_barrier(const XcdBarrier& b) {
    asm volatile("s_waitcnt vmcnt(0)" ::: "memory");
    __syncthreads();
    if (threadIdx.x == 0) {
        unsigned* bar = b.bar;
        __builtin_amdgcn_s_waitcnt(0);
        unsigned nloc = b.st[0], nx = b.st[1];
        if (nloc == 0u) { xcd_barrier_complete(bar, b.x, nloc, nx); b.st[0] = nloc; b.st[1] = nx; }
        const unsigned old = xb_add(&bar[XB_XSUB(b.x)], 1u);
        const unsigned gen = old / nloc;
        if (old + 1u == (gen + 1u) * nloc) {
            __builtin_amdgcn_fence(__ATOMIC_RELEASE, "agent");
            asm volatile("s_waitcnt vmcnt(0)" ::: "memory");
            const unsigned og = xb_add(&bar[XB_TOP], 1u);
            const unsigned tg = og / nx;
            if (og + 1u == (tg + 1u) * nx) xb_add(&bar[XB_TOPGEN], 1u);
            else XB_SPIN(xb_ld(&bar[XB_TOPGEN]) == tg, bar);
            __builtin_amdgcn_fence(__ATOMIC_ACQUIRE, "agent");
            xb_add(&bar[XB_XGEN(b.x)], 1u);
            asm volatile("s_waitcnt vmcnt(0)" ::: "memory");
        } else {
            XB_SPIN(xb_ld(&bar[XB_XGEN(b.x)]) == gen, bar);
            __builtin_amdgcn_fence(__ATOMIC_ACQUIRE, "agent");
            asm volatile("s_waitcnt vmcnt(0)" ::: "memory");
        }
    }
    __syncthreads();
}

struct Frame {
    LAS unsigned char* lds;
    int tid, lane, wave;
    int gw, ngw;
    int cu, G;
};
DI Frame mk_frame(LAS unsigned char* lds) {
    Frame F; F.lds = lds; F.tid = ltid(); F.lane = F.tid & 63; F.wave = __builtin_amdgcn_readfirstlane(F.tid >> 6);
    F.cu = blockIdx.x; F.G = gridDim.x; F.gw = F.wave * F.G + F.cu; F.ngw = F.G * 8; return F;
}
DI unsigned char* wl(const Params& P, int l) { return P.ws + WS_W + (size_t)l * WL_SIZE; }

DI void transpose_item(const float* W, int ldw, int k0, int n0, int nvalid, const float* gain, bf16_t* dst, int row0, int ldk, int koff, LAS float* scr, int lane) {
    const int kr = lane >> 3, nq = lane & 7;
    f32x4 v[8];
#pragma unroll
    for (int i = 0; i < 8; ++i) { const int kk = 8 * i + kr; v[i] = (4 * nq < nvalid) ? *(const f32x4*)(W + (size_t)(k0 + kk) * ldw + n0 + 4 * nq) : (f32x4){0.f, 0.f, 0.f, 0.f}; }
#pragma unroll
    for (int i = 0; i < 8; ++i) { const int kk = 8 * i + kr; f32x4 x = v[i]; if (gain) x = x * gain[k0 + kk];
        LAS float* sp = scr + kk * 33 + 4 * nq; sp[0] = x.x; sp[1] = x.y; sp[2] = x.z; sp[3] = x.w; }
    LDS_WAIT();
    const int c = lane & 7;
#pragma unroll
    for (int j = 0; j < 4; ++j) { const int nn = (lane >> 3) + 8 * j; const LAS float* s = scr + (8 * c) * 33 + nn;
        u32x4 o; o.x = pk2(s[0 * 33], s[1 * 33]); o.y = pk2(s[2 * 33], s[3 * 33]); o.z = pk2(s[4 * 33], s[5 * 33]); o.w = pk2(s[6 * 33], s[7 * 33]);
        *(u32x4*)(dst + (size_t)(row0 + nn) * ldk + koff + k0 + 8 * c) = o; }
    LDS_WAIT();
}
constexpr int WI_IN = 16 * 208, WI_GU = 16 * 176, WI_DN = 44 * 32, WI_OUT = 16 * 32, WI_BR = 3 * 8 * 32, WI_MEM = 16 * 32, WI_W1 = 2 * 2 * 16 * 4, WI_W2 = 8;
constexpr int WI_LAYER = WI_IN + WI_GU + WI_DN + WI_OUT + WI_BR + WI_MEM + WI_W1 + WI_W2;
DI void weight_item(const Params& P, int l, int r, LAS float* scr, int lane) {
    unsigned char* W = wl(P, l);
    if (r < WI_IN) { const int kb = r / 208, db = r % 208; int src, nv = 32;
        if (db < 40) src = 32 * db; else if (db < 200) src = 32 * db + 24; else if (db == 200) { src = 1280; nv = 24; } else { src = 0; nv = 0; }
        transpose_item(P.w_in + (size_t)l * 1024 * N_IN, N_IN, 64 * kb, src, nv, P.norm_mix + l * 1024, (bf16_t*)(W + WL_WIN), 32 * db, 1024, 0, scr, lane); return; } r -= WI_IN;
    if (r < WI_GU) { const int kb = r / 176, db = r % 176, tile = db >> 3, w = db & 7; const int src = (w < 4) ? 128 * tile + 32 * w : D_FF + 128 * tile + 32 * (w - 4);
        transpose_item(P.w_gate_up + (size_t)l * 1024 * 5632, 5632, 64 * kb, src, 32, P.norm_ffn + l * 1024, (bf16_t*)(W + WL_WGU), 32 * db, 1024, 0, scr, lane); return; } r -= WI_GU;
    if (r < WI_DN) { const int kb = r / 32, db = r % 32;
        transpose_item(P.w_down + (size_t)l * D_FF * 1024, 1024, 64 * kb, 32 * db, 32, nullptr, (bf16_t*)(W + WL_WDN), 32 * db, D_FF, 0, scr, lane); return; } r -= WI_DN;
    if (r < WI_OUT) { const int kb = r / 32, db = r % 32;
        transpose_item(P.w_out + (size_t)l * 1024 * 1024, 1024, 64 * kb, 32 * db, 32, nullptr, (bf16_t*)(W + WL_WOUT), 32 * db, 1024, 0, scr, lane); return; } r -= WI_OUT;
    if (r < WI_BR) { const int br = r / 256, q = r % 256, kb = q / 32, db = q % 32;
        transpose_item(P.w_branch + ((size_t)l * 3 + br) * 512 * 1024, 1024, 64 * kb, 32 * db, 32, nullptr, (bf16_t*)(W + WL_WBR), 32 * db, 1536, 512 * br, scr, lane); return; } r -= WI_BR;
    if (r < WI_MEM) { const int kb = r / 32, db = r % 32;
        transpose_item(P.w_mem_kv + (size_t)l * 1024 * 1024, 1024, 64 * kb, 32 * db, 32, P.norm_mem + l * 1024, (bf16_t*)(W + WL_WMEM), 32 * db, 1024, 0, scr, lane); return; } r -= WI_MEM;
    if (r < WI_W1) { const int c = r / 128, q = r % 128, half = q / 64, q2 = q % 64, kb = q2 / 4, db = q2 % 4;
        transpose_item(P.cmp_w1 + ((size_t)(l * 2 + c) * 2048 + half * 1024) * 128, 128, 64 * kb, 32 * db, 32, nullptr, (bf16_t*)(W + WL_W1C) + (size_t)c * 256 * 1024, half * 128 + 32 * db, 1024, 0, scr, lane); return; } r -= WI_W1;
    { const int c = r / 4, q = r % 4, kb = q / 2, db = q % 2;
        transpose_item(P.cmp_w2 + (size_t)(l * 2 + c) * 128 * 64, 64, 64 * kb, 32 * db, 32, nullptr, (bf16_t*)(W + WL_W2T) + (size_t)c * 64 * 128, 32 * db, 128, 0, scr, lane); }
}
DI void row_to_bf16_rinv(const float* xrow, bf16_t* orow, float* rinv, int lane, bool raw) {
    const f32x4* xr = (const f32x4*)xrow + lane;
    f32x4 v[4]; float s = 0.f;
#pragma unroll
    for (int j = 0; j < 4; ++j) { v[j] = xr[64 * j]; s += (v[j].x * v[j].x + v[j].y * v[j].y) + (v[j].z * v[j].z + v[j].w * v[j].w); }
    s = wave_sum(s);
    u32x2* o8 = (u32x2*)orow + lane;
#pragma unroll
    for (int j = 0; j < 4; ++j) { u32x2 w; w.x = pk2(v[j].x, v[j].y); w.y = pk2(v[j].z, v[j].w); o8[64 * j] = w; }
    if (lane == 0) *rinv = raw ? s : 1.0f / sqrtf(s * (1.0f / 1024.0f) + EPS);
}
DI const float* xrow_in(const Params& P, int l, int m) {
    if (l == 0) return (m < MP) ? P.x_prompt + (size_t)m * 1024 : P.x_sample + (size_t)(m - MP) * 1024;
    return (const float*)(P.ws + WS_XNEXT) + (size_t)m * 1024;
}
DI void cache_item(const Params& P, int it, int lane) {
    const int l = it / 2048, r = it % 2048, b = r / 64, pg = r % 64;
    const int phys = P.page_table[b * 64 + pg];
    const float* src = P.cache_nsa + ((size_t)l * NPHYS + phys) * (128 * 512) + lane * 4;
    const int c = lane >> 5, g = (lane >> 4) & 1, d = 4 * (lane & 15);
    bf16_t* dstb = (bf16_t*)(P.ws + WS_AC) + (size_t)(l * 2 + c) * 32768 * 1024;
#pragma unroll 8
    for (int pos = 0; pos < 128; ++pos) {
        const f32x4 v = *(const f32x4*)(src + (size_t)pos * 512);
        const int jj = pos >> 4, s = pos & 15; const size_t row = (size_t)(b * 512 + 8 * pg + jj) * 2 + g;
        u32x2 w; w.x = pk2(v.x, v.y); w.y = pk2(v.z, v.w);
        *(u32x2*)(dstb + row * 1024 + s * 64 + d) = w;
    }
}
DI void cbias_item(const Params& P, int it, int lane) {
    const int l = it / 16, c = (it / 8) & 1, part = it & 7;
    const float* pe = P.cmp_pe + (size_t)(l * 2 + c) * 2048 + part * 256;
    const float* w1 = P.cmp_w1 + ((size_t)(l * 2 + c) * 2048 + part * 256) * 128;
    float a0 = 0.f, a1 = 0.f;
#pragma unroll 8
    for (int k = 0; k < 256; ++k) { const float p = pe[k]; a0 += p * w1[k * 128 + lane]; a1 += p * w1[k * 128 + 64 + lane]; }
    float* o = (float*)(wl(P, l) + WL_CBP) + (c * 8 + part) * 128;
    o[lane] = a0; o[64 + lane] = a1;
}
constexpr int WI_LATE = WI_LAYER - WI_MEM - WI_W1 - WI_W2;
constexpr int PA_CACHE = 0, PA_W = WI_LAYER + WI_MEM + WI_W1 + WI_W2, PA_X = MP + MS, PA_MEM = 1024, PA_CB = 32;
DI void phase_pa(const Params& P, const Frame& F) {
    LAS float* scr = (LAS float*)(F.lds + F.wave * 16384);
    constexpr int NIT = PA_CACHE + PA_W + PA_X + PA_MEM + PA_CB;
    for (int it = F.gw; it < NIT; it += F.ngw) {
        int r = it;
        if (r < PA_CACHE) { cache_item(P, r, F.lane); continue; } r -= PA_CACHE;
        if (r < PA_W) { if (r < WI_LAYER) weight_item(P, 0, r, scr, F.lane); else weight_item(P, 1, WI_LATE + (r - WI_LAYER), scr, F.lane); continue; } r -= PA_W;
        if (r < PA_X) { row_to_bf16_rinv(xrow_in(P, 0, r), (bf16_t*)(P.ws + WS_XB) + (size_t)r * 1024, (float*)(P.ws + WS_RINV) + r, F.lane, true); continue; } r -= PA_X;
        if (r < PA_MEM) { row_to_bf16_rinv(P.mem_prompt + (size_t)r * 1024, (bf16_t*)(P.ws + WS_MEMB) + (size_t)r * 1024, (float*)(P.ws + WS_RINVM) + r, F.lane, false); continue; } r -= PA_MEM;
        cbias_item(P, r, F.lane);
    }
}
typedef f32x4 (&AccRef)[2][2][4][2];
DI void load_rows8(const float* p, int row0, float (&r)[8]) {
#pragma unroll
    for (int q = 0; q < 8; ++q) r[q] = p[row0 + (q >> 2) * 128 + (q & 3) * 16];
    asm volatile("" : "+v"(r[0]), "+v"(r[1]), "+v"(r[2]), "+v"(r[3]), "+v"(r[4]), "+v"(r[5]), "+v"(r[6]), "+v"(r[7]));
}
DI float rinv_of(float ssq) { return __builtin_amdgcn_rsqf(ssq * (1.0f / 1024.0f) + EPS); }
struct EpiInproj {
    static constexpr bool PERM = true, CARRY = false;
    bf16_t* H; const float* ssq;
    DI void operator()(AccRef acc, const pg8::Unit& u, int wr, int wc, int fr, int fq) const {
        const int row0 = u.pm * 256 + wr * 64 + fr, col0 = u.pn * 256 + wc * 32 + 8 * fq; const bool sig = u.pn >= SIG_TILE;
#pragma unroll
        for (int ai = 0; ai < 2; ++ai)
#pragma unroll
            for (int m = 0; m < 4; ++m) { const int row = row0 + ai * 128 + m * 16; const float ri = rinv_of(ssq[row]); bf16_t* rp = H + (size_t)row * LDH + col0;
#pragma unroll
                for (int bj = 0; bj < 2; ++bj) { float v[8];
#pragma unroll
                    for (int n = 0; n < 2; ++n)
#pragma unroll
                        for (int e = 0; e < 4; ++e) { float x = acc[ai][bj][m][n][e] * ri; if (sig) x = sigmoidf_(x); v[n * 4 + e] = x; }
                    *(u32x4*)(rp + bj * 128) = pack8(v); } }
    }
};
DI void rope_cs(int pos, int i, float& c, float& s);
struct EpiInprojF {
    static constexpr bool PERM = true, CARRY = false;
    bf16_t* H; const float* ssq; LAS float* xs; const LAS float* gt; int l;
    bf16_t *QC, *QR, *KS, *KW, *VST, *VWT, *MQ; float* out;
    DI void operator()(AccRef acc, const pg8::Unit& u, int wr, int wc, int fr0, int fq) const {
        int fr = fr0; asm volatile("" : "+v"(fr));
        const int pn = u.pn, wid = wr * 4 + wc, row0 = u.pm * 256 + wr * 64 + fr, cw = wc * 32 + 8 * fq;
        LAS float* xsl = xs + (wid * 128 + fr) * 2;
        const LAS float* xsp = xs + ((wid ^ 1) * 128 + fr) * 2;
        const LAS float* xsq = xs + (wr * 4 * 128 + fr) * 2;
        const bool fusedk = (pn <= 1) || pn == 3 || pn == 4 || pn == 11 || pn == 12;
        if (!fusedk) {
            const bool sig = pn >= SIG_TILE; const int col0 = pn * 256 + cw;
            float rir[8];
            load_rows8(ssq, row0, rir);
#pragma unroll
            for (int q = 0; q < 8; ++q) rir[q] = rinv_of(rir[q]);
#pragma unroll
            for (int ai = 0; ai < 2; ++ai)
#pragma unroll
                for (int m = 0; m < 4; ++m) { const int row = row0 + ai * 128 + m * 16; const float ri = rir[ai * 4 + m]; bf16_t* rp = H + (size_t)row * LDH + col0;
#pragma unroll
                    for (int bj = 0; bj < 2; ++bj) { float v[8];
#pragma unroll
                        for (int n = 0; n < 2; ++n)
#pragma unroll
                            for (int e = 0; e < 4; ++e) { float x = acc[ai][bj][m][n][e] * ri; if (sig) { const float ee = 1.0f + fexp2(-x * LOG2E); x = (pn == 25) ? frcp(ee) : ee; } v[n * 4 + e] = x; }
                        *(u32x4*)(rp + bj * 128) = pack8(v);
                        if (pn == 2) { float* ro = out + O_ROWS + ((size_t)l * MP + row) * 512 + bj * 128 + cw;
                            *(f32x4*)ro = (f32x4){v[0], v[1], v[2], v[3]}; *(f32x4*)(ro + 4) = (f32x4){v[4], v[5], v[6], v[7]}; } } }
            return;
        }
        if (pn <= 1) fused<0>(acc, pn, wr, wc, fr, fq, row0, cw, xsl, xsp, xsq);
        else if (pn <= 4) fused<1>(acc, pn, wr, wc, fr, fq, row0, cw, xsl, xsp, xsq);
        else fused<2>(acc, pn, wr, wc, fr, fq, row0, cw, xsl, xsp, xsq);
    }
    template <int KIND>
    DI void fused(AccRef acc, int pn, int wr, int wc, int fr, int fq, int row0, int cw, LAS float* xsl, const LAS float* xsp, const LAS float* xsq) const {
        constexpr bool isq = KIND == 0, iskv = KIND == 1, ismq = KIND == 2;
        float rir[8];
        load_rows8(ssq, row0, rir);
#pragma unroll
        for (int q = 0; q < 8; ++q) rir[q] = rinv_of(rir[q]);
#pragma unroll
        for (int ai = 0; ai < 2; ++ai)
#pragma unroll
            for (int m = 0; m < 4; ++m) { const float ri = rir[ai * 4 + m];
#pragma unroll
                for (int bj = 0; bj < 2; ++bj) { float ss = 0.f;
#pragma unroll
                    for (int n = 0; n < 2; ++n)
#pragma unroll
                        for (int e = 0; e < 4; ++e) { const float x = acc[ai][bj][m][n][e]; ss += x * x; }
                    ss *= ri * ri;
                    ss += __shfl_xor(ss, 16); ss += __shfl_xor(ss, 32);
                    if (fq == 0) xsl[(ai * 4 + m) * 32 + bj] = ss; } }
        asm volatile("s_waitcnt lgkmcnt(0)" ::: "memory"); __builtin_amdgcn_s_barrier(); asm volatile("" ::: "memory");
        const int hd0 = (wc & 1) * 32 + 8 * fq;
#pragma unroll
        for (int ai = 0; ai < 2; ++ai)
#pragma unroll
            for (int m = 0; m < 4; ++m) { const int row = row0 + ai * 128 + m * 16, t = row & 4095, b = row >> 12; const float ri = rir[ai * 4 + m];
                float cs[8], sn[8];
                if (!ismq && (wc & 1) == 0) {
#pragma unroll
                    for (int j = 0; j < 8; ++j) rope_cs(t, j, cs[j], sn[j]); }
#pragma unroll
                for (int bj = 0; bj < 2; ++bj) {
                    const bool norm = isq || ismq || (iskv && bj == 0);
                    float hn = 1.f;
                    if (norm) { float tot; const int so = (ai * 4 + m) * 32 + bj;
                        if (ismq) tot = (xsq[so] + xsq[256 + so]) + (xsq[512 + so] + xsq[768 + so]);
                        else tot = xsl[so] + xsp[so];
                        hn = __builtin_amdgcn_rsqf(tot * (ismq ? (1.0f / 128.0f) : (1.0f / 64.0f)) + EPS); }
                    const LAS float* gp = gt + (isq ? 0 : (iskv ? (pn == 3 ? 64 : 128) : 192)) + (ismq ? cw : hd0);
                    const float sc = ri * hn * (isq ? C2 : (ismq ? C2M : 1.0f));
                    float y[8];
#pragma unroll
                    for (int n = 0; n < 2; ++n)
#pragma unroll
                        for (int e = 0; e < 4; ++e) { const int j = n * 4 + e; y[j] = acc[ai][bj][m][n][e] * (norm ? sc * gp[j] : ri); }
                    float yr[8];
#pragma unroll
                    for (int j = 0; j < 8; ++j) yr[j] = y[j];
                    if (norm && !ismq && (wc & 1) == 0) {
#pragma unroll
                        for (int j = 0; j < 8; ++j) { const float o = __shfl_xor(y[j], 16); if (fq < 2) yr[j] = y[j] * cs[j] + (fq == 0 ? -o : o) * sn[j]; } }
                    if (isq) { const int head = pn * 4 + bj * 2 + (wc >> 1);
                        *(u32x4*)(QC + (size_t)row * 512 + head * 64 + hd0) = pack8(y); *(u32x4*)(QR + (size_t)row * 512 + head * 64 + hd0) = pack8(yr); }
                    else if (ismq) { const int head = (pn - 11) * 2 + bj;
                        *(u32x4*)(MQ + (size_t)row * 512 + head * 128 + cw) = pack8(y); }
                    else { const int g = wc >> 1;
                        if (pn == 3) { float* ro = out + O_ROWS + ((size_t)l * MP + row) * 512 + (2 + bj) * 128 + g * 64 + hd0;
                            *(f32x4*)ro = (f32x4){yr[0], yr[1], yr[2], yr[3]}; *(f32x4*)(ro + 4) = (f32x4){yr[4], yr[5], yr[6], yr[7]}; }
                        else if (t >= SEQ - 512) { float* wo = out + O_WIN + ((((size_t)l * 4 + b) * 512 + (t - (SEQ - 512))) * 2 + bj) * 128 + g * 64 + hd0;
                            *(f32x4*)wo = (f32x4){yr[0], yr[1], yr[2], yr[3]}; *(f32x4*)(wo + 4) = (f32x4){yr[4], yr[5], yr[6], yr[7]}; }
                        if (bj == 0) { bf16_t* kp = (pn == 3 ? KS : KW) + ((size_t)row * 2 + g) * 64 + hd0; *(u32x4*)kp = pack8(yr); }
                        else { bf16_t* vp = (pn == 3 ? VST : VWT) + ((size_t)(b * 2 + g) * 64 + hd0) * 4096 + t;
#pragma unroll
                            for (int j = 0; j < 8; ++j) vp[(size_t)j * 4096] = (bf16_t)f2bf(yr[j]); } }
                } }
        asm volatile("s_waitcnt lgkmcnt(0)" ::: "memory"); __builtin_amdgcn_s_barrier(); asm volatile("" ::: "memory");
    }
};
struct EpiPlainBf16 {
    static constexpr bool PERM = true, CARRY = false;
    bf16_t* O; size_t gstride; int ldc;
    DI void operator()(AccRef acc, const pg8::Unit& u, int wr, int wc, int fr, int fq) const {
        const int row0 = u.pm * 256 + wr * 64 + fr, col0 = u.pn * 256 + wc * 32 + 8 * fq; bf16_t* base = O + (size_t)u.grp * gstride;
#pragma unroll
        for (int ai = 0; ai < 2; ++ai)
#pragma unroll
            for (int m = 0; m < 4; ++m) { bf16_t* rp = base + (size_t)(row0 + ai * 128 + m * 16) * ldc + col0;
#pragma unroll
                for (int bj = 0; bj < 2; ++bj) { float v[8];
#pragma unroll
                    for (int n = 0; n < 2; ++n)
#pragma unroll
                        for (int e = 0; e < 4; ++e) v[n * 4 + e] = acc[ai][bj][m][n][e];
                    *(u32x4*)(rp + bj * 128) = pack8(v); } }
    }
};
struct EpiScaleF32 {
    static constexpr bool PERM = false, CARRY = false;
    float* O; size_t gstride; int ldc; const float* rs;
    DI void operator()(AccRef acc, const pg8::Unit& u, int wr, int wc, int fr, int fq) const {
        const int row0 = u.pm * 256 + wr * 64 + fr, col0 = u.pn * 256 + wc * 32 + 4 * fq; float* base = O + (size_t)u.grp * gstride;
        float rir[8];
        load_rows8(rs, row0, rir);
#pragma unroll
        for (int ai = 0; ai < 2; ++ai)
#pragma unroll
            for (int m = 0; m < 4; ++m) { const int row = row0 + ai * 128 + m * 16; const float ri = rir[ai * 4 + m]; float* rp = base + (size_t)row * ldc + col0;
#pragma unroll
                for (int bj = 0; bj < 2; ++bj)
#pragma unroll
                    for (int n = 0; n < 2; ++n) *(f32x4*)(rp + bj * 128 + n * 16) = acc[ai][bj][m][n] * ri; }
    }
};
struct EpiBranch {
    static constexpr bool PERM = true, CARRY = true;
    bf16_t* MG; const bf16_t* H;
    DI void operator()(AccRef acc, const pg8::Unit& u, int wr, int wc, int fr, int fq) const {
        const int row0 = u.pm * 256 + wr * 64 + fr, col0 = u.pn * 256 + wc * 32 + 8 * fq;
#pragma unroll
        for (int ai = 0; ai < 2; ++ai) {
            u32x4 ga[4][2], gb[4][2];
#pragma unroll
            for (int m = 0; m < 4; ++m) { const bf16_t* gp = H + (size_t)(row0 + ai * 128 + m * 16) * LDH + HMG + u.kb * 1024 + col0;
#pragma unroll
                for (int bj = 0; bj < 2; ++bj) { ga[m][bj] = *(const u32x4*)(gp + bj * 128); gb[m][bj] = (u.kb < 2) ? *(const u32x4*)(gp + 1024 + bj * 128) : (u32x4){0u, 0u, 0u, 0u}; } }
#pragma unroll
            for (int m = 0; m < 4; ++m) { const int row = row0 + ai * 128 + m * 16;
#pragma unroll
                for (int bj = 0; bj < 2; ++bj) { float g0[8], g1[8]; unpack8(ga[m][bj], g0); unpack8(gb[m][bj], g1);
                    if (u.kb < 2) {
#pragma unroll
                        for (int n = 0; n < 2; ++n)
#pragma unroll
                            for (int e = 0; e < 4; ++e) { const int i = n * 4 + e; acc[ai][bj][m][n][e] *= g1[i] * frcp(g0[i]); }
                    } else { float v[8];
#pragma unroll
                        for (int n = 0; n < 2; ++n)
#pragma unroll
                            for (int e = 0; e < 4; ++e) { const int i = n * 4 + e; v[i] = acc[ai][bj][m][n][e] * frcp(g0[i]); }
                        *(u32x4*)(MG + (size_t)row * 1024 + col0 + bj * 128) = pack8(v); } } } }
    }
};
struct EpiResidual {
    static constexpr bool PERM = false, CARRY = false;
    const float* base; float* O; bf16_t* OB; float* ssq;
    DI void operator()(AccRef acc, const pg8::Unit& u, int wr, int wc, int fr, int fq) const {
        const int row0 = u.pm * 256 + wr * 64 + fr, col0 = u.pn * 256 + wc * 32 + 4 * fq;
#pragma unroll
        for (int ai = 0; ai < 2; ++ai) {
            f32x4 br[4][2][2];
#pragma unroll
            for (int m = 0; m < 4; ++m) { const float* bp = base + (size_t)(row0 + ai * 128 + m * 16) * 1024 + col0;
#pragma unroll
                for (int bj = 0; bj < 2; ++bj)
#pragma unroll
                    for (int n = 0; n < 2; ++n) br[m][bj][n] = *(const f32x4*)(bp + bj * 128 + n * 16); }
#pragma unroll
            for (int m = 0; m < 4; ++m) { const int row = row0 + ai * 128 + m * 16; float* rp = O + (size_t)row * 1024 + col0; float ss = 0.f;
#pragma unroll
                for (int bj = 0; bj < 2; ++bj)
#pragma unroll
                    for (int n = 0; n < 2; ++n) { const f32x4 v = br[m][bj][n] + acc[ai][bj][m][n]; *(f32x4*)(rp + bj * 128 + n * 16) = v;
                        if (OB) { u32x2 w; w.x = pk2(v.x, v.y); w.y = pk2(v.z, v.w); *(u32x2*)(OB + (size_t)row * 1024 + col0 + bj * 128 + n * 16) = w; ss += (v.x * v.x + v.y * v.y) + (v.z * v.z + v.w * v.w); } }
                if (OB) { ss += __shfl_xor(ss, 16); ss += __shfl_xor(ss, 32); if (fq == 0) atomicAdd(ssq + row, ss); } } }
    }
};
struct EpiGateUp {
    static constexpr bool PERM = true, CARRY = false;
    bf16_t* ACT; const float* ssq;
    DI void operator()(AccRef acc, const pg8::Unit& u, int wr, int wc, int fr, int fq) const {
        const int row0 = u.pm * 256 + wr * 64 + fr, f0 = u.pn * 128 + wc * 32 + 8 * fq;
        float rir[8];
        load_rows8(ssq, row0, rir);
#pragma unroll
        for (int q = 0; q < 8; ++q) rir[q] = rinv_of(rir[q]);
#pragma unroll
        for (int ai = 0; ai < 2; ++ai)
#pragma unroll
            for (int m = 0; m < 4; ++m) { const int row = row0 + ai * 128 + m * 16; const float ri = rir[ai * 4 + m]; float v[8];
#pragma unroll
                for (int n = 0; n < 2; ++n)
#pragma unroll
                    for (int e = 0; e < 4; ++e) { const float g = acc[ai][0][m][n][e] * ri, uu = acc[ai][1][m][n][e] * ri; v[n * 4 + e] = g * sigmoidf_(g) * uu; }
                *(u32x4*)(ACT + (size_t)row * D_FF + f0) = pack8(v); }
    }
};

template <int NSEG, class AP, class BP>
DI void small_gemm_tile(LAS unsigned char* lds, int K, const AP& ap, const BP& bp) {
    const int tid = ltid(), wid = __builtin_amdgcn_readfirstlane(tid >> 6), lane = tid & 63, r32 = lane & 31, hi = lane >> 5;
    const int kper = K / 8, k0 = wid * kper;
    LAS float* red = (LAS float*)lds; LAS float* fin = (LAS float*)(lds + NSEG * 32768);
    __syncthreads();
    f32x16 acc[NSEG];
#pragma unroll
    for (int seg = 0; seg < NSEG; ++seg) {
        acc[seg] = f32x16{};
        for (int kb = k0; kb < k0 + kper; kb += 64) {
            bf16x8 bfr[4], afr[4];
#pragma unroll
            for (int q = 0; q < 4; ++q) { const int k = kb + 16 * q; const bool ok = k < k0 + kper; const int kc = ok ? k : kb;
                bfr[q] = *(const bf16x8*)bp(seg, r32, kc + 8 * hi); afr[q] = *(const bf16x8*)ap(seg, r32, kc + 8 * hi); if (!ok) afr[q] = (bf16x8){0, 0, 0, 0, 0, 0, 0, 0}; }
#pragma unroll
            for (int q = 0; q < 4; ++q) acc[seg] = MFMA32(bfr[q], afr[q], acc[seg]);
        }
    }
#pragma unroll
    for (int seg = 0; seg < NSEG; ++seg)
#pragma unroll
        for (int r = 0; r < 16; ++r) red[(seg * 8 + wid) * 1024 + crow(r, hi) * 32 + r32] = acc[seg][r];
    __syncthreads();
    for (int e = tid; e < NSEG * 1024; e += 512) { const int seg = e >> 10, ee = e & 1023; float s = 0.f;
#pragma unroll
        for (int w = 0; w < 8; ++w) s += red[(seg * 8 + w) * 1024 + ee];
        fin[e] = s; }
    __syncthreads();
}

DI void ugemm_unit(const Params& P, int grp, int pmq, LAS unsigned char* lds) {
    using namespace pg8;
    const int tid = ltid(), wid = __builtin_amdgcn_readfirstlane(tid >> 6), lane = tid & 63, wr = wid >> 2, wc = wid & 3, fr = lane & 15, fq = lane >> 4;
    const int l = grp >> 1, c = grp & 1;
    const float* asrc[2];
    const int sb = pmq / 9, st = pmq - 9 * sb;
#pragma unroll
    for (int i = 0; i < 2; ++i) { int R, C; stage_rc(tid * 16 + i * 8192, R, C); const int b = sb, jj = 63 * st + (R >> 1), j = jj < 511 ? jj : 511, g = R & 1;
        asrc[i] = P.cache_nsa + (((size_t)l * NPHYS + P.page_table[b * 64 + (j >> 3)]) * 128 + (j & 7) * 16) * 512 + c * 128 + g * 64 + C; }
    unsigned voffB[2];
#pragma unroll
    for (int i = 0; i < 2; ++i) { int R, C; stage_rc(tid * 16 + i * 8192, R, C); const int Rb = (R & ~31) + perm32(R & 31); voffB[i] = (unsigned)(Rb * 1024 + C) * 2u; }
    const char* cB = (const char*)(wl(P, l) + WL_W1C) + (size_t)c * (256 * 1024 * 2);
    const unsigned ldsw = (unsigned)wid * 1024u;
    const int aoff = lds_byte(wr * 64 + fr, fq * 8), boff = lds_byte(wc * 32 + fr, fq * 8);
#define UG_SA(b) ((b) * HTB)
#define UG_SB(b, h) (32768 + ((b) * 2 + (h)) * HTB)
#define UG_STAGEB(buf, ks) do { _Pragma("unroll") for (int h_ = 0; h_ < 2; ++h_) _Pragma("unroll") for (int _i = 0; _i < 2; ++_i) \
        __builtin_amdgcn_global_load_lds((const unsigned*)(cB + (size_t)h_ * (128 * 1024 * 2) + (size_t)(ks) * 128 + voffB[_i]), (LAS unsigned*)(lds + UG_SB(buf, h_) + ldsw + _i * 8192), 16, 0, 0); } while (0)
    f32x4 ar0[2][2], ar1[2][2];
#define UG_LOADA(R, ks) do { _Pragma("unroll") for (int _i = 0; _i < 2; ++_i) { const float* p_ = asrc[_i] + (size_t)(ks) * 512; \
        asm volatile("global_load_dwordx4 %0, %1, off" : "=v"(R[_i][0]) : "v"(p_) : "memory"); asm volatile("global_load_dwordx4 %0, %1, off offset:16" : "=v"(R[_i][1]) : "v"(p_) : "memory"); } } while (0)
#define UG_WAITA(R, n) asm volatile("s_waitcnt vmcnt(" #n ")" : "+v"(R[0][0]), "+v"(R[0][1]), "+v"(R[1][0]), "+v"(R[1][1]) :: "memory")
#define UG_WRITEA(R, buf) do { _Pragma("unroll") for (int _i = 0; _i < 2; ++_i) { u32x4 w_; w_.x = pk2(R[_i][0].x, R[_i][0].y); w_.y = pk2(R[_i][0].z, R[_i][0].w); w_.z = pk2(R[_i][1].x, R[_i][1].y); w_.w = pk2(R[_i][1].z, R[_i][1].w); \
        *(LAS u32x4*)(lds + UG_SA(buf) + tid * 16 + _i * 8192) = w_; } } while (0)
    bf16x8 At[4][2], B0[2][2], B1[2][2];
#define UG_READ(cur) do { \
        _Pragma("unroll") for (int m = 0; m < 4; ++m) _Pragma("unroll") for (int k = 0; k < 2; ++k) At[m][k] = *(const LAS bf16x8*)(lds + UG_SA(cur) + aoff + m * 2048 + k * 1024); \
        _Pragma("unroll") for (int n = 0; n < 2; ++n) _Pragma("unroll") for (int k = 0; k < 2; ++k) { B0[n][k] = *(const LAS bf16x8*)(lds + UG_SB(cur, 0) + boff + n * 2048 + k * 1024); B1[n][k] = *(const LAS bf16x8*)(lds + UG_SB(cur, 1) + boff + n * 2048 + k * 1024); } \
        asm volatile("s_waitcnt lgkmcnt(0)" ::: "memory"); __builtin_amdgcn_sched_barrier(0); } while (0)
#define UG_MMA() do { _Pragma("unroll") for (int m = 0; m < 4; ++m) _Pragma("unroll") for (int n = 0; n < 2; ++n) _Pragma("unroll") for (int k = 0; k < 2; ++k) { acc[0][m][n] = MFMA16(B0[n][k], At[m][k], acc[0][m][n]); acc[1][m][n] = MFMA16(B1[n][k], At[m][k], acc[1][m][n]); } } while (0)
    f32x4 acc[2][4][2];
#pragma unroll
    for (int b = 0; b < 2; ++b)
#pragma unroll
        for (int m = 0; m < 4; ++m)
#pragma unroll
            for (int n = 0; n < 2; ++n) acc[b][m][n] = (f32x4){0.f, 0.f, 0.f, 0.f};
    __syncthreads();
    UG_STAGEB(0, 0); UG_LOADA(ar0, 0); UG_LOADA(ar1, 1);
    UG_WAITA(ar0, 4); UG_WRITEA(ar0, 0);
    asm volatile("s_waitcnt vmcnt(4) lgkmcnt(0)" ::: "memory"); __builtin_amdgcn_s_barrier();
#pragma unroll 1
    for (int ks = 0; ks < 16; ks += 2) {
        UG_READ(0); UG_STAGEB(1, ks + 1); UG_LOADA(ar0, ks + 2 < 16 ? ks + 2 : 15); __builtin_amdgcn_sched_barrier(0);
        UG_MMA();
        UG_WAITA(ar1, 8); UG_WRITEA(ar1, 1);
        asm volatile("s_waitcnt vmcnt(4) lgkmcnt(0)" ::: "memory"); __builtin_amdgcn_s_barrier();
        UG_READ(1); UG_STAGEB(0, ks + 2 < 16 ? ks + 2 : 15); UG_LOADA(ar1, ks + 3 < 16 ? ks + 3 : 15); __builtin_amdgcn_sched_barrier(0);
        UG_MMA();
        UG_WAITA(ar0, 8); UG_WRITEA(ar0, 0);
        asm volatile("s_waitcnt vmcnt(4) lgkmcnt(0)" ::: "memory"); __builtin_amdgcn_s_barrier();
    }
    UG_WAITA(ar1, 0);
    constexpr int PU = 528;
    LAS unsigned char* ut = lds; LAS float* cbl = (LAS float*)(lds + 128 * PU);
    __syncthreads();
#pragma unroll
    for (int m = 0; m < 4; ++m) { LAS unsigned char* rp = ut + (wr * 64 + m * 16 + fr) * PU + (wc * 32 + 8 * fq) * 2;
#pragma unroll
        for (int bj = 0; bj < 2; ++bj) { float v[8];
#pragma unroll
            for (int n = 0; n < 2; ++n)
#pragma unroll
                for (int e = 0; e < 4; ++e) v[n * 4 + e] = acc[bj][m][n][e];
            *(LAS u32x4*)(rp + bj * 256) = pack8(v); } }
    if (tid < 128) { const float* cp = (const float*)(wl(P, l) + WL_CBP) + c * 1024; float a = 0.f;
#pragma unroll
        for (int q = 0; q < 8; ++q) a += cp[q * 128 + tid];
        cbl[tid] = a; }
    { const int tr = lane & 15, q = lane >> 4, g = wid & 1, jl = 16 * (wid >> 1) + tr, i = 63 * st + jl; const bool valid = (jl < 63) && (i < 511);
      const bf16_t* W2T = (const bf16_t*)(wl(P, l) + WL_W2T) + (size_t)c * 64 * 128;
      u32x4 w2[4][4];
#pragma unroll
      for (int ct = 0; ct < 4; ++ct)
#pragma unroll
          for (int s2 = 0; s2 < 4; ++s2) w2[ct][s2] = *(const u32x4*)(W2T + (size_t)(16 * ct + tr) * 128 + 32 * s2 + 8 * q);
      __syncthreads();
      const int r0 = 2 * jl + g, r1 = (jl < 63) ? r0 + 2 : r0;
      bf16x8 bfr[4];
#pragma unroll
      for (int s2 = 0; s2 < 4; ++s2) { const int n0 = 32 * s2 + 8 * q; float a[8], bb[8], h[8];
          unpack8(*(const LAS u32x4*)(ut + r0 * PU + n0 * 2), a); unpack8(*(const LAS u32x4*)(ut + r1 * PU + (128 + n0) * 2), bb);
#pragma unroll
          for (int j2 = 0; j2 < 8; ++j2) { const float x = a[j2] + bb[j2] + cbl[n0 + j2]; h[j2] = x * sigmoidf_(x); }
          bfr[s2] = __builtin_bit_cast(bf16x8, pack8(h)); }
      f32x4 fa[4];
#pragma unroll
      for (int ct = 0; ct < 4; ++ct) { fa[ct] = (f32x4){0.f, 0.f, 0.f, 0.f};
#pragma unroll
          for (int s2 = 0; s2 < 4; ++s2) fa[ct] = MFMA16(__builtin_bit_cast(bf16x8, w2[ct][s2]), bfr[s2], fa[ct]); }
      if (c == 0) { float ss = 0.f; const float* knorm = P.k_norm + (l * 3 + 0) * 64;
#pragma unroll
          for (int ct = 0; ct < 4; ++ct) ss += (fa[ct].x * fa[ct].x + fa[ct].y * fa[ct].y) + (fa[ct].z * fa[ct].z + fa[ct].w * fa[ct].w);
          ss += __shfl_xor(ss, 16); ss += __shfl_xor(ss, 32);
          const float ri = 1.0f / sqrtf(ss * (1.0f / 64.0f) + EPS);
#pragma unroll
          for (int ct = 0; ct < 4; ++ct) { const f32x4 gn = *(const f32x4*)(knorm + 16 * ct + 4 * q); fa[ct] = fa[ct] * ri * gn; } }
      float* O = (float*)(P.ws + (c ? WS_VCS : WS_KCS)) + ((size_t)(l * 32 + sb) * 2 + g) * 512 * 64;
      if (valid) {
#pragma unroll
          for (int ct = 0; ct < 4; ++ct) *(f32x4*)(O + (size_t)i * 64 + 16 * ct + 4 * q) = fa[ct]; } }
#undef UG_SA
#undef UG_SB
#undef UG_STAGEB
#undef UG_LOADA
#undef UG_WRITEA
#undef UG_WAITA
#undef UG_READ
#undef UG_MMA
}
DI void rope_cs(int pos, int i, float& c, float& s) {
    constexpr float INV2PI[8] = {0.15915494309189535f, 0.03086376340470123f, 0.005985185712713705f, 0.001160663641240061f,
                                 0.00022507907903927653f, 4.364795279280289e-05f, 8.464330808241401e-06f, 1.6414262627950345e-06f};
    const float tf = __builtin_amdgcn_fractf((float)pos * INV2PI[i]);
    s = __builtin_amdgcn_sinf(tf); c = __builtin_amdgcn_cosf(tf);
}
DI void post_row(const Params& P, int l, int m, int lane) {
    const bool smp = m >= MP; const int b = smp ? (m - MP) : (m >> 12), t = smp ? 0 : (m & 4095), pos = smp ? PAST : t;
    const bf16_t* Hr = (const bf16_t*)(P.ws + WS_H) + (size_t)m * LDH;
    float cs[8], sn[8];
#pragma unroll
    for (int i = 0; i < 8; ++i) rope_cs(pos, i, cs[i], sn[i]);
    const int sub = lane & 7;
    {
        float v[8]; unpack8(*(const u32x4*)(Hr + HQ + 8 * lane), v);
        float ss = 0.f;
#pragma unroll
        for (int j = 0; j < 8; ++j) ss += v[j] * v[j];
        ss += __shfl_xor(ss, 1); ss += __shfl_xor(ss, 2); ss += __shfl_xor(ss, 4);
        const float ri = 1.0f / sqrtf(ss * (1.0f / 64.0f) + EPS);
        const float* gn = P.q_norm + l * 64 + 8 * sub;
        float y[8], yc[8], yr[8];
#pragma unroll
        for (int j = 0; j < 8; ++j) { y[j] = v[j] * ri * gn[j]; yc[j] = y[j] * C2; }
#pragma unroll
        for (int j = 0; j < 8; ++j) { const float o = __shfl_xor(y[j], 1);
            float r = y[j];
            if (sub == 0) r = y[j] * cs[j] - o * sn[j]; else if (sub == 1) r = y[j] * cs[j] + o * sn[j];
            yr[j] = r * C2; }
        *(u32x4*)((bf16_t*)(P.ws + WS_QC) + (size_t)m * 512 + 8 * lane) = pack8(yc);
        *(u32x4*)((bf16_t*)(P.ws + WS_QR) + (size_t)m * 512 + 8 * lane) = pack8(yr);
    }
    float* rows_out = smp ? P.out + O_ROWSS + ((size_t)l * 32 + b) * 512 : P.out + O_ROWS + (((size_t)l * 4 + b) * 4096 + t) * 512;
#pragma unroll
    for (int pass = 0; pass < 2; ++pass) {
        const int vi = pass * 8 + (lane >> 3); const bool act = vi < 12; const int vic = act ? vi : 0;
        const int br = vic >> 2, kvsel = (vic >> 1) & 1, g = vic & 1;
        float v[8]; unpack8(*(const u32x4*)(Hr + HKV + vic * 64 + 8 * sub), v);
        float ss = 0.f;
#pragma unroll
        for (int j = 0; j < 8; ++j) ss += v[j] * v[j];
        ss += __shfl_xor(ss, 1); ss += __shfl_xor(ss, 2); ss += __shfl_xor(ss, 4);
        const float ri = 1.0f / sqrtf(ss * (1.0f / 64.0f) + EPS);
        const bool isk = (kvsel == 0) && (br >= 1);
        const float* gn = P.k_norm + (l * 3 + (isk ? br : 1)) * 64 + 8 * sub;
        float y[8];
#pragma unroll
        for (int j = 0; j < 8; ++j) y[j] = isk ? v[j] * ri * gn[j] : v[j];
#pragma unroll
        for (int j = 0; j < 8; ++j) { const float o = __shfl_xor(y[j], 1);
            if (isk) { if (sub == 0) y[j] = y[j] * cs[j] - o * sn[j]; else if (sub == 1) y[j] = y[j] * cs[j] + o * sn[j]; } }
        if (act) {
            const int d0 = 8 * sub;
            if (br <= 1) {
                const int kind = br * 2 + kvsel; float* ro = rows_out + kind * 128 + g * 64 + d0;
                *(f32x4*)ro = (f32x4){y[0], y[1], y[2], y[3]}; *(f32x4*)(ro + 4) = (f32x4){y[4], y[5], y[6], y[7]};
            }
            if (br == 2) {
                float* wo = nullptr;
                if (smp) wo = P.out + O_WINS + ((((size_t)l * 32 + b) * 512 + 511) * 2 + kvsel) * 128 + g * 64 + d0;
                else if (t >= SEQ - 512) wo = P.out + O_WIN + ((((size_t)l * 4 + b) * 512 + (t - (SEQ - 512))) * 2 + kvsel) * 128 + g * 64 + d0;
                if (wo) { *(f32x4*)wo = (f32x4){y[0], y[1], y[2], y[3]}; *(f32x4*)(wo + 4) = (f32x4){y[4], y[5], y[6], y[7]}; }
            }
            if (!smp && br >= 1) {
                if (kvsel == 0) { bf16_t* kp = (bf16_t*)(P.ws + (br == 1 ? WS_KS : WS_KW)) + ((size_t)m * 2 + g) * 64 + d0; *(u32x4*)kp = pack8(y); }
                else { bf16_t* vp = (bf16_t*)(P.ws + (br == 1 ? WS_VST : WS_VWT)) + ((size_t)(b * 2 + g) * 64 + d0) * 4096 + t;
#pragma unroll
                    for (int j = 0; j < 8; ++j) vp[(size_t)j * 4096] = (bf16_t)f2bf(y[j]); }
            }
        }
    }
    {
        const int ch = 8 * lane; float cx[8], cb[8], cc[8], u0[8], u1[8], u2[8];
        unpack8(*(const u32x4*)(Hr + HCX + ch), cx); unpack8(*(const u32x4*)(Hr + HCB + ch), cb); unpack8(*(const u32x4*)(Hr + HCC + ch), cc);
#pragma unroll
        for (int j = 0; j < 8; ++j) u0[j] = cc[j] * cx[j];
        if (smp) {
            const float* st = P.state_conv + ((size_t)l * 32 + b) * 2 * 512 + ch;
#pragma unroll
            for (int j = 0; j < 8; ++j) { u2[j] = st[j]; u1[j] = st[512 + j]; }
            float* co = P.out + O_CONVS + ((size_t)l * 32 + b) * 2 * 512 + ch;
#pragma unroll
            for (int j = 0; j < 8; ++j) { co[j] = u1[j]; co[512 + j] = u0[j]; }
        } else {
#pragma unroll
            for (int j = 0; j < 8; ++j) { u1[j] = 0.f; u2[j] = 0.f; }
            if (t >= 1) { float a[8], c2[8]; unpack8(*(const u32x4*)(Hr - LDH + HCX + ch), a); unpack8(*(const u32x4*)(Hr - LDH + HCC + ch), c2);
#pragma unroll
                for (int j = 0; j < 8; ++j) u1[j] = a[j] * c2[j]; }
            if (t >= 2) { float a[8], c2[8]; unpack8(*(const u32x4*)(Hr - 2 * LDH + HCX + ch), a); unpack8(*(const u32x4*)(Hr - 2 * LDH + HCC + ch), c2);
#pragma unroll
                for (int j = 0; j < 8; ++j) u2[j] = a[j] * c2[j]; }
            if (t >= SEQ - 2) { float* co = P.out + O_CONV + (((size_t)l * 4 + b) * 2 + (t - (SEQ - 2))) * 512 + ch;
#pragma unroll
                for (int j = 0; j < 8; ++j) co[j] = u0[j]; }
        }
        const float* cw = P.conv_w + (size_t)l * 3 * 512 + ch; float z[8];
#pragma unroll
        for (int j = 0; j < 8; ++j) z[j] = cb[j] * (cw[j] * u2[j] + cw[512 + j] * u1[j] + cw[1024 + j] * u0[j]);
        *(u32x4*)((bf16_t*)(P.ws + WS_BR) + (size_t)m * 1536 + 512 + ch) = pack8(z);
    }
    {
        float v[8]; unpack8(*(const u32x4*)(Hr + HMQ + 8 * lane), v);
        float ss = 0.f;
#pragma unroll
        for (int j = 0; j < 8; ++j) ss += v[j] * v[j];
        ss += __shfl_xor(ss, 1); ss += __shfl_xor(ss, 2); ss += __shfl_xor(ss, 4); ss += __shfl_xor(ss, 8);
        const float ri = 1.0f / sqrtf(ss * (1.0f / 128.0f) + EPS);
        const float* gn = P.mem_q_norm + l * 128 + 8 * (lane & 15); float y[8];
#pragma unroll
        for (int j = 0; j < 8; ++j) y[j] = v[j] * ri * gn[j] * C2M;
        *(u32x4*)((bf16_t*)(P.ws + WS_MQ) + (size_t)m * 512 + 8 * lane) = pack8(y);
    }
}
DI void wincopy_rows(const Params& P, int l, int blk, int lane) {
    f32x4 v[7];
#pragma unroll
    for (int q = 0; q < 7; ++q) { const int r = 7 * blk + q, b = r / 511, i = r % 511; v[q] = *((const f32x4*)(P.cache_win + (((size_t)l * 32 + b) * 512 + i + 1) * 256) + lane); }
#pragma unroll
    for (int q = 0; q < 7; ++q) { const int r = 7 * blk + q, b = r / 511, i = r % 511; *((f32x4*)(P.out + O_WINS + (((size_t)l * 32 + b) * 512 + i) * 256) + lane) = v[q]; }
}
DI void memkv_row(const Params& P, int it, int lane) {
    const int lm = it / 1024, r = it % 1024, b = r >> 8, mm = r & 255;
    const float* src = (const float*)(P.ws + WS_MKVRAW) + ((size_t)lm * 1024 + r) * 1024;
    float* dst = P.out + O_MKV + ((size_t)lm * 1024 + r) * 1024;
    { float v[8]; const f32x4 a = *(const f32x4*)(src + 8 * lane), c = *(const f32x4*)(src + 8 * lane + 4);
      v[0] = a.x; v[1] = a.y; v[2] = a.z; v[3] = a.w; v[4] = c.x; v[5] = c.y; v[6] = c.z; v[7] = c.w;
      float ss = 0.f;
#pragma unroll
      for (int j = 0; j < 8; ++j) ss += v[j] * v[j];
      ss += __shfl_xor(ss, 1); ss += __shfl_xor(ss, 2); ss += __shfl_xor(ss, 4); ss += __shfl_xor(ss, 8);
      const float ri = 1.0f / sqrtf(ss * (1.0f / 128.0f) + EPS); const float* gn = P.mem_k_norm + lm * 128 + 8 * (lane & 15);
#pragma unroll
      for (int j = 0; j < 8; ++j) v[j] = v[j] * ri * gn[j];
      *(f32x4*)(dst + 8 * lane) = (f32x4){v[0], v[1], v[2], v[3]}; *(f32x4*)(dst + 8 * lane + 4) = (f32x4){v[4], v[5], v[6], v[7]};
      const int h = lane >> 4, d0 = 8 * (lane & 15);
      *(u32x4*)((bf16_t*)(P.ws + WS_MK) + ((((size_t)lm * 4 + b) * 4 + h) * 256 + mm) * 128 + d0) = pack8(v); }
    { float v[8]; const f32x4 a = *(const f32x4*)(src + 512 + 8 * lane), c = *(const f32x4*)(src + 512 + 8 * lane + 4);
      v[0] = a.x; v[1] = a.y; v[2] = a.z; v[3] = a.w; v[4] = c.x; v[5] = c.y; v[6] = c.z; v[7] = c.w;
      *(f32x4*)(dst + 512 + 8 * lane) = a; *(f32x4*)(dst + 512 + 8 * lane + 4) = c;
      const int h = lane >> 4, d0 = 8 * (lane & 15); bf16_t* vp = (bf16_t*)(P.ws + WS_MVT) + ((((size_t)lm * 4 + b) * 4 + h) * 128 + d0) * 256 + mm;
#pragma unroll
      for (int j = 0; j < 8; ++j) vp[(size_t)j * 256] = (bf16_t)f2bf(v[j]); }
}

template <int NB> DI void postb_q(const Params& P, int l, int m0, int lane, const u32x4 (&raw)[NB]) {
    const int sub = lane & 7;
    float gn[8];
#pragma unroll
    for (int j = 0; j < 8; ++j) gn[j] = P.q_norm[l * 64 + 8 * sub + j];
#pragma unroll
    for (int r = 0; r < NB; ++r) { const int m = m0 + r, pos = m & 4095;
        float v[8]; unpack8(raw[r], v); float ss = 0.f;
#pragma unroll
        for (int j = 0; j < 8; ++j) ss += v[j] * v[j];
        ss += __shfl_xor(ss, 1); ss += __shfl_xor(ss, 2); ss += __shfl_xor(ss, 4);
        const float ri = 1.0f / sqrtf(ss * (1.0f / 64.0f) + EPS); float y[8], yc[8], yr[8];
#pragma unroll
        for (int j = 0; j < 8; ++j) { y[j] = v[j] * ri * gn[j]; yc[j] = y[j] * C2; }
#pragma unroll
        for (int j = 0; j < 8; ++j) { const float o = __shfl_xor(y[j], 1); float rr = y[j];
            if (sub < 2) { float c, sn; rope_cs(pos, j, c, sn); rr = y[j] * c + (sub == 0 ? -o : o) * sn; }
            yr[j] = rr * C2; }
        *(u32x4*)((bf16_t*)(P.ws + WS_QC) + (size_t)m * 512 + 8 * lane) = pack8(yc);
        *(u32x4*)((bf16_t*)(P.ws + WS_QR) + (size_t)m * 512 + 8 * lane) = pack8(yr); }
}
template <int NB> DI void postb_kv(const Params& P, int l, int m0, int r0, int pass, int lane, LAS bf16_t* vt, const u32x4 (&raw)[NB]) {
    const int vi = pass * 8 + (lane >> 3), sub = lane & 7; const bool act = vi < 12; const int vic = act ? vi : 0;
    const int br = vic >> 2, kvsel = (vic >> 1) & 1, g = vic & 1, d0 = 8 * sub;
    const bool isk = (kvsel == 0) && (br >= 1);
    float gn[8];
#pragma unroll
    for (int j = 0; j < 8; ++j) gn[j] = P.k_norm[(l * 3 + (isk ? br : 1)) * 64 + d0 + j];
#pragma unroll
    for (int r = 0; r < NB; ++r) { const int m = m0 + r0 + r, b = m >> 12, t = m & 4095;
        float v[8]; unpack8(raw[r], v); float ss = 0.f;
#pragma unroll
        for (int j = 0; j < 8; ++j) ss += v[j] * v[j];
        ss += __shfl_xor(ss, 1); ss += __shfl_xor(ss, 2); ss += __shfl_xor(ss, 4);
        const float ri = 1.0f / sqrtf(ss * (1.0f / 64.0f) + EPS); float y[8];
#pragma unroll
        for (int j = 0; j < 8; ++j) y[j] = isk ? v[j] * ri * gn[j] : v[j];
#pragma unroll
        for (int j = 0; j < 8; ++j) { const float o = __shfl_xor(y[j], 1);
            if (isk && sub < 2) { float c, sn; rope_cs(t, j, c, sn); y[j] = y[j] * c + (sub == 0 ? -o : o) * sn; } }
        if (act) {
            if (br <= 1) { float* ro = P.out + O_ROWS + (((size_t)l * 4 + b) * 4096 + t) * 512 + (br * 2 + kvsel) * 128 + g * 64 + d0;
                *(f32x4*)ro = (f32x4){y[0], y[1], y[2], y[3]}; *(f32x4*)(ro + 4) = (f32x4){y[4], y[5], y[6], y[7]}; }
            if (br == 2 && t >= SEQ - 512) { float* wo = P.out + O_WIN + ((((size_t)l * 4 + b) * 512 + (t - (SEQ - 512))) * 2 + kvsel) * 128 + g * 64 + d0;
                *(f32x4*)wo = (f32x4){y[0], y[1], y[2], y[3]}; *(f32x4*)(wo + 4) = (f32x4){y[4], y[5], y[6], y[7]}; }
            if (br >= 1) {
                if (kvsel == 0) { bf16_t* kp = (bf16_t*)(P.ws + (br == 1 ? WS_KS : WS_KW)) + ((size_t)m * 2 + g) * 64 + d0; *(u32x4*)kp = pack8(y); }
                else { LAS bf16_t* vp = vt + (((br - 1) * 2 + g) * 64 + d0) * 8 + (r0 + r);
#pragma unroll
                    for (int j = 0; j < 8; ++j) vp[j * 8] = (bf16_t)f2bf(y[j]); } } } }
}
DI void postb_vflush(const Params& P, int m0, int lane, const LAS bf16_t* vt) {
    const int b = m0 >> 12, t0 = m0 & 4095;
#pragma unroll
    for (int i = 0; i < 4; ++i) { const int c = lane + 64 * i, brm = c >> 7, g = (c >> 6) & 1, d = c & 63;
        const u32x4 w = *(const LAS u32x4*)(vt + c * 8);
        *(u32x4*)((bf16_t*)(P.ws + (brm == 0 ? WS_VST : WS_VWT)) + ((size_t)(b * 2 + g) * 64 + d) * 4096 + t0) = w; }
}
template <int NB> DI void postb_conv(const Params& P, int l, int m0, int r0, int lane, const u32x4 (&rx)[NB + 2], const u32x4 (&rc)[NB + 2], const u32x4 (&rb)[NB]) {
    const int ch = 8 * lane;
    float w0[8], w1[8], w2[8];
    { const float* cw = P.conv_w + (size_t)l * 3 * 512 + ch;
#pragma unroll
      for (int j = 0; j < 8; ++j) { w0[j] = cw[j]; w1[j] = cw[512 + j]; w2[j] = cw[1024 + j]; } }
    float u[NB + 2][8];
#pragma unroll
    for (int r = 0; r < NB + 2; ++r) { float a[8], c[8]; unpack8(rx[r], a); unpack8(rc[r], c);
#pragma unroll
        for (int j = 0; j < 8; ++j) u[r][j] = a[j] * c[j]; }
#pragma unroll
    for (int r = 0; r < NB; ++r) { const int m = m0 + r0 + r, b = m >> 12, t = m & 4095; float cb[8], z[8]; unpack8(rb[r], cb);
#pragma unroll
        for (int j = 0; j < 8; ++j) z[j] = cb[j] * (w0[j] * u[r][j] + w1[j] * u[r + 1][j] + w2[j] * u[r + 2][j]);
        *(u32x4*)((bf16_t*)(P.ws + WS_BR) + (size_t)m * 1536 + 512 + ch) = pack8(z);
        if (t >= SEQ - 2) { float* co = P.out + O_CONV + (((size_t)l * 4 + b) * 2 + (t - (SEQ - 2))) * 512 + ch;
#pragma unroll
            for (int j = 0; j < 8; ++j) co[j] = u[r + 2][j]; } }
}
template <int NB> DI void postb_mq(const Params& P, int l, int m0, int lane, const u32x4 (&raw)[NB]) {
    float gn[8];
#pragma unroll
    for (int j = 0; j < 8; ++j) gn[j] = P.mem_q_norm[l * 128 + 8 * (lane & 15) + j] * C2M;
#pragma unroll
    for (int r = 0; r < NB; ++r) { float v[8]; unpack8(raw[r], v); float ss = 0.f;
#pragma unroll
        for (int j = 0; j < 8; ++j) ss += v[j] * v[j];
        ss += __shfl_xor(ss, 1); ss += __shfl_xor(ss, 2); ss += __shfl_xor(ss, 4); ss += __shfl_xor(ss, 8);
        const float ri = 1.0f / sqrtf(ss * (1.0f / 128.0f) + EPS); float y[8];
#pragma unroll
        for (int j = 0; j < 8; ++j) y[j] = v[j] * ri * gn[j];
        *(u32x4*)((bf16_t*)(P.ws + WS_MQ) + (size_t)(m0 + r) * 512 + 8 * lane) = pack8(y); }
}
#define OPAQ(x) asm volatile("" : "+v"(x))
DI void post_half(const Params& P, int l, int m1, int rofs, int lane0, LAS bf16_t* vt) {
    int lane = lane0; OPAQ(lane);
    const bf16_t* Hm = (const bf16_t*)(P.ws + WS_H) + (size_t)m1 * LDH; const int sub = lane & 7, t1 = m1 & 4095;
    u32x4 rq[4], rk0[4], rk1[4], rx[6], rc[6], rb[4], rm[4];
    const int vi1 = 8 + (lane >> 3), vic1 = vi1 < 12 ? vi1 : 0;
#pragma unroll
    for (int r = 0; r < 4; ++r) { const bf16_t* hr = Hm + (size_t)r * LDH;
        rq[r] = *(const u32x4*)(hr + HQ + 8 * lane); rk0[r] = *(const u32x4*)(hr + HKV + (lane >> 3) * 64 + 8 * sub); rk1[r] = *(const u32x4*)(hr + HKV + vic1 * 64 + 8 * sub);
        rb[r] = *(const u32x4*)(hr + HCB + 8 * lane); rm[r] = *(const u32x4*)(hr + HMQ + 8 * lane); }
#pragma unroll
    for (int r = 0; r < 6; ++r) { const bool ok = t1 + r - 2 >= 0; const bf16_t* hp = Hm + ((long)r - 2) * LDH + 8 * lane;
        rx[r] = ok ? *(const u32x4*)(hp + HCX) : (u32x4){0u, 0u, 0u, 0u}; rc[r] = ok ? *(const u32x4*)(hp + HCC) : (u32x4){0u, 0u, 0u, 0u}; }
    postb_q<4>(P, l, m1, lane, rq);
    OPAQ(lane); postb_kv<4>(P, l, m1 - rofs, rofs, 0, lane, vt, rk0);
    OPAQ(lane); postb_kv<4>(P, l, m1 - rofs, rofs, 1, lane, vt, rk1);
    OPAQ(lane); postb_conv<4>(P, l, m1 - rofs, rofs, lane, rx, rc, rb);
    OPAQ(lane); postb_mq<4>(P, l, m1, lane, rm);
}
DI void post_block8(const Params& P, int l, int m0, int lane, LAS bf16_t* vt) {
    post_half(P, l, m0, 0, lane, vt);
    post_half(P, l, m0 + 4, 4, lane, vt);
    LDS_WAIT();
    postb_vflush(P, m0, lane, vt);
    LDS_WAIT();
}

DI void post_conv8(const Params& P, int l, int m0, int lane0) {
#pragma unroll
    for (int hf = 0; hf < 2; ++hf) { int lane = lane0; OPAQ(lane);
        const int m1 = m0 + 4 * hf, t1 = m1 & 4095; const bf16_t* Hm = (const bf16_t*)(P.ws + WS_H) + (size_t)m1 * LDH;
        u32x4 rx[6], rc[6], rb[4];
#pragma unroll
        for (int r = 0; r < 4; ++r) rb[r] = *(const u32x4*)(Hm + (size_t)r * LDH + HCB + 8 * lane);
#pragma unroll
        for (int r = 0; r < 6; ++r) { const bool ok = t1 + r - 2 >= 0; const bf16_t* hp = Hm + ((long)r - 2) * LDH + 8 * lane;
            rx[r] = ok ? *(const u32x4*)(hp + HCX) : (u32x4){0u, 0u, 0u, 0u}; rc[r] = ok ? *(const u32x4*)(hp + HCC) : (u32x4){0u, 0u, 0u, 0u}; }
        postb_conv<4>(P, l, m1 - 4 * hf, 4 * hf, lane, rx, rc, rb); }
}
DI void cmpu_wave(const Params& P, int l, int it, int lane) {
    const int c = it >> 9, mt = (it >> 3) & 63, nt = it & 7, r32 = lane & 31, hi = lane >> 5;
    const int r = 32 * mt + r32, b = r >> 9, j = (r >> 1) & 255, g = r & 1;
    const bf16_t* ap = (const bf16_t*)(P.ws + WS_H) + ((size_t)b * 4096 + 16 * j) * LDH + HKV + c * 128 + g * 64 + 8 * hi;
    const bf16_t* bp = (const bf16_t*)(wl(P, l) + WL_W1C) + (size_t)c * 256 * 1024 + (size_t)(32 * nt + r32) * 1024 + 8 * hi;
    f32x16 acc = {};
#pragma unroll 2
    for (int s = 0; s < 16; ++s) {
        bf16x8 af[4], bf[4];
#pragma unroll
        for (int q = 0; q < 4; ++q) { af[q] = *(const bf16x8*)(ap + (size_t)s * LDH + 16 * q); bf[q] = *(const bf16x8*)(bp + 64 * s + 16 * q); }
#pragma unroll
        for (int q = 0; q < 4; ++q) acc = MFMA32(bf[q], af[q], acc);
    }
    bf16_t* U = (bf16_t*)(P.ws + WS_UP) + (size_t)c * 2048 * 256 + (size_t)r * 256 + 32 * nt;
#pragma unroll
    for (int rg = 0; rg < 4; ++rg) { u32x2 w; w.x = pk2(acc[4 * rg], acc[4 * rg + 1]); w.y = pk2(acc[4 * rg + 2], acc[4 * rg + 3]); *(u32x2*)(U + 8 * rg + 4 * hi) = w; }
}
template <class OutW>
DI void cmp_finalize_tile(const bf16_t* U, int Jn, int nblk, int seq, int g, int i0, const float* cbias  , const bf16_t* W2T  , const float* knorm  , int lane, const OutW& ow) {
    const int tr = lane & 15, q = lane >> 4, i = i0 + tr; const bool valid = i < nblk; const int ic = valid ? i : (nblk - 1);
    const bf16_t* u0p = U + ((size_t)(seq * Jn + ic) * 2 + g) * 256; const bf16_t* u1p = U + ((size_t)(seq * Jn + ic + 1) * 2 + g) * 256 + 128;
    bf16x8 bfr[4]; u32x4 ua[4], ub[4];
#pragma unroll
    for (int s = 0; s < 4; ++s) { ua[s] = *(const u32x4*)(u0p + 32 * s + 8 * q); ub[s] = *(const u32x4*)(u1p + 32 * s + 8 * q); }
#pragma unroll
    for (int s = 0; s < 4; ++s) { const int n0 = 32 * s + 8 * q; float a[8], b[8], h[8];
        unpack8(ua[s], a); unpack8(ub[s], b);
#pragma unroll
        for (int j = 0; j < 8; ++j) { const float x = a[j] + b[j] + cbias[n0 + j]; h[j] = x * sigmoidf_(x); }
        bfr[s] = __builtin_bit_cast(bf16x8, pack8(h)); }
    u32x4 w2[4][4];
#pragma unroll
    for (int ct = 0; ct < 4; ++ct)
#pragma unroll
        for (int s = 0; s < 4; ++s) w2[ct][s] = *(const u32x4*)(W2T + (size_t)(16 * ct + tr) * 128 + 32 * s + 8 * q);
#pragma unroll
    for (int ct = 0; ct < 4; ++ct) asm volatile("" : "+v"(w2[ct][0]), "+v"(w2[ct][1]), "+v"(w2[ct][2]), "+v"(w2[ct][3]));
    f32x4 acc[4];
#pragma unroll
    for (int ct = 0; ct < 4; ++ct) { acc[ct] = (f32x4){0.f, 0.f, 0.f, 0.f};
#pragma unroll
        for (int s = 0; s < 4; ++s) acc[ct] = MFMA16(__builtin_bit_cast(bf16x8, w2[ct][s]), bfr[s], acc[ct]); }
    if (knorm) { float ss = 0.f;
#pragma unroll
        for (int ct = 0; ct < 4; ++ct) ss += (acc[ct].x * acc[ct].x + acc[ct].y * acc[ct].y) + (acc[ct].z * acc[ct].z + acc[ct].w * acc[ct].w);
        ss += __shfl_xor(ss, 16); ss += __shfl_xor(ss, 32);
        const float ri = 1.0f / sqrtf(ss * (1.0f / 64.0f) + EPS);
#pragma unroll
        for (int ct = 0; ct < 4; ++ct) { const f32x4 gn = *(const f32x4*)(knorm + 16 * ct + 4 * q); acc[ct] = acc[ct] * ri * gn; } }
#pragma unroll
    for (int ct = 0; ct < 4; ++ct) ow(i, 16 * ct + 4 * q, acc[ct], valid);
}
DI void cmps_task(const Params& P, int it, int lane) {
    const int c = it & 1, l = (it >> 1) & 1, tile = (it >> 2) & 31, g = (it >> 7) & 1, b = it >> 8;
    const bf16_t* U = (const bf16_t*)(P.ws + WS_US) + (size_t)(l * 2 + c) * 32768 * 256;
    float* O = (float*)(P.ws + (c ? WS_VCS : WS_KCS)) + ((size_t)(l * 32 + b) * 2 + g) * 512 * 64;
    auto ow = [&](int i, int e0, f32x4 v, bool valid) { if (valid) *(f32x4*)(O + (size_t)i * 64 + e0) = v; };
    cmp_finalize_tile(U, 512, 511, b, g, 16 * tile, (const float*)(wl(P, l) + WL_CBF) + c * 128, (const bf16_t*)(wl(P, l) + WL_W2T) + (size_t)c * 64 * 128,
                      c ? nullptr : P.k_norm + (l * 3 + 0) * 64, lane, ow);
}
DI void cmpp_task(const Params& P, int l, int it, int lane) {
    const int c = it & 1, tile = (it >> 1) & 15, g = (it >> 5) & 1, b = it >> 6;
    const bf16_t* U = (const bf16_t*)(P.ws + WS_UP) + (size_t)c * 2048 * 256;
    bf16_t* KC = (bf16_t*)(P.ws + WS_KC) + (size_t)(b * 2 + g) * 256 * 64; bf16_t* VCT = (bf16_t*)(P.ws + WS_VCT) + (size_t)(b * 2 + g) * 64 * 256;
    auto ow = [&](int i, int e0, f32x4 v, bool valid) { if (!valid) v = (f32x4){0.f, 0.f, 0.f, 0.f};
        if (i < 256) { if (c == 0) { u32x2 w; w.x = pk2(v.x, v.y); w.y = pk2(v.z, v.w); *(u32x2*)(KC + (size_t)i * 64 + e0) = w; }
                       else { VCT[(size_t)(e0 + 0) * 256 + i] = (bf16_t)f2bf(v.x); VCT[(size_t)(e0 + 1) * 256 + i] = (bf16_t)f2bf(v.y); VCT[(size_t)(e0 + 2) * 256 + i] = (bf16_t)f2bf(v.z); VCT[(size_t)(e0 + 3) * 256 + i] = (bf16_t)f2bf(v.w); } } };
    cmp_finalize_tile(U, 256, 255, b, g, 16 * tile, (const float*)(wl(P, l) + WL_CBF) + c * 128, (const bf16_t*)(wl(P, l) + WL_W2T) + (size_t)c * 64 * 128,
                      c ? nullptr : P.k_norm + (l * 3 + 0) * 64, lane, ow);
}
constexpr int OC_STASH = 98304;
template <int HDIM, int HDV> struct FlashGeo {
    static constexpr int KP = HDIM * 2 + 16;
    static constexpr int KT = 64 * KP;
    static constexpr int VP = 144;
    static constexpr int VT = HDV * VP;
    static constexpr int BUF = KT + VT;
    static constexpr int NCH = HDIM / 64;
    static constexpr int NCV = HDV / 64;
};
template <int HDIM, int HDV, class TA>
DI void flash_pass(LAS unsigned char* lds, const bf16x8 (&qf)[HDIM / 16], f32x16 (&o)[HDV / 32], float& l_run, int ntiles, const TA& ta, float negB) {
    typedef FlashGeo<HDIM, HDV> G;
    const int tid = ltid(), lane = tid & 63, c32 = lane & 31, hi = lane >> 5;
    u32x4 kreg[G::NCH], vreg[G::NCV];
    auto issue = [&](int tile) {
#pragma unroll
        for (int i = 0; i < G::NCH; ++i) { const int id = tid + i * 512; kreg[i] = *(const u32x4*)ta.kptr(tile, id / (HDIM / 8), id % (HDIM / 8)); }
#pragma unroll
        for (int i = 0; i < G::NCV; ++i) { const int id = tid + i * 512; vreg[i] = *(const u32x4*)ta.vptr(tile, id >> 3, id & 7); } };
    auto commit = [&](LAS unsigned char* buf) {
#pragma unroll
        for (int i = 0; i < G::NCH; ++i) { const int id = tid + i * 512; *(LAS u32x4*)(buf + (id / (HDIM / 8)) * G::KP + (id % (HDIM / 8)) * 16) = kreg[i]; }
#pragma unroll
        for (int i = 0; i < G::NCV; ++i) { const int id = tid + i * 512;
            const int ch = id & 7; LAS unsigned char* vp = buf + G::KT + (id >> 3) * G::VP + (ch >> 1) * 32 + (ch & 1) * 8;
            *(LAS u32x2*)vp = (u32x2){vreg[i].x, vreg[i].y}; *(LAS u32x2*)(vp + 16) = (u32x2){vreg[i].z, vreg[i].w}; } };
    if (ntiles <= 0) return;
    issue(ta.tile(0)); commit(lds); __syncthreads();
    for (int it = 0; it < ntiles; ++it) {
        const int tile = ta.tile(it);
        const bool more = it + 1 < ntiles;
        if (more) issue(ta.tile(it + 1));
        const LAS unsigned char* buf = lds + (it & 1) * G::BUF;
        f32x16 p0, p1;
#pragma unroll
        for (int r = 0; r < 16; ++r) { p0[r] = negB; p1[r] = negB; }
        const LAS unsigned char* kb = buf + c32 * G::KP + hi * 16;
#pragma unroll
        for (int c = 0; c < HDIM / 16; ++c) {
            const bf16x8 a0 = *(const LAS bf16x8*)(kb + c * 32), a1 = *(const LAS bf16x8*)(kb + 32 * G::KP + c * 32);
            p0 = MFMA32(a0, qf[c], p0); p1 = MFMA32(a1, qf[c], p1);
            if ((c & 3) == 3) __builtin_amdgcn_sched_barrier(0);
        }
        ta.mask(tile, p0, p1);
        float ps = 0.f;
#pragma unroll
        for (int r = 0; r < 16; ++r) { p0[r] = fexp2(p0[r]); p1[r] = fexp2(p1[r]); ps += p0[r] + p1[r]; }
        l_run += ps;
        bf16x8 pf[2][2];
#pragma unroll
        for (int s = 0; s < 2; ++s) {
            u32x4 w0, w1;
            w0.x = pk2(p0[8 * s + 0], p0[8 * s + 1]); w0.y = pk2(p0[8 * s + 2], p0[8 * s + 3]); w0.z = pk2(p0[8 * s + 4], p0[8 * s + 5]); w0.w = pk2(p0[8 * s + 6], p0[8 * s + 7]);
            w1.x = pk2(p1[8 * s + 0], p1[8 * s + 1]); w1.y = pk2(p1[8 * s + 2], p1[8 * s + 3]); w1.z = pk2(p1[8 * s + 4], p1[8 * s + 5]); w1.w = pk2(p1[8 * s + 6], p1[8 * s + 7]);
            pf[0][s] = __builtin_bit_cast(bf16x8, w0); pf[1][s] = __builtin_bit_cast(bf16x8, w1);
        }
        const LAS unsigned char* vb = buf + G::KT + c32 * G::VP + hi * 16;
#pragma unroll
        for (int db = 0; db < HDV / 32; ++db)
#pragma unroll
            for (int kh = 0; kh < 2; ++kh)
#pragma unroll
                for (int s = 0; s < 2; ++s) {
                    const bf16x8 vf = *(const LAS bf16x8*)(vb + db * 32 * G::VP + kh * 64 + s * 32);
                    o[db] = MFMA32(vf, pf[kh][s], o[db]);
                }
        if (more) commit(lds + ((it + 1) & 1) * G::BUF);
        __syncthreads();
    }
}

template <class TA>
DI void flash_pass_pipe(LAS unsigned char* lds, const bf16x8 (&qf)[4], f32x16 (&o)[2], float& l_run, int ntiles, const TA& ta, const f32x16& cinit) {
    typedef FlashGeo<64, 64> G;
    const int tid = ltid(), lane = tid & 63, c32 = lane & 31, hi = lane >> 5;
    if (ntiles <= 0) return;
    u32x4 kA, vA;
    const int krow = tid >> 3, kch = tid & 7;
    auto issueA = [&](int tile) { kA = *(const u32x4*)ta.kptr(tile, krow, kch); vA = *(const u32x4*)ta.vptr(tile, krow, kch); };
    auto commit_ = [&](LAS unsigned char* buf, const u32x4& kreg, const u32x4& vreg) {
        *(LAS u32x4*)(buf + krow * G::KP + kch * 16) = kreg;
        LAS unsigned char* vp = buf + G::KT + krow * G::VP + (kch >> 1) * 32 + (kch & 1) * 8;
        *(LAS u32x2*)vp = (u32x2){vreg.x, vreg.y}; *(LAS u32x2*)(vp + 16) = (u32x2){vreg.z, vreg.w}; };
    auto qk = [&](const LAS unsigned char* buf, f32x16& p0, f32x16& p1) {
        const LAS unsigned char* kb = buf + c32 * G::KP + hi * 16;
        bf16x8 kf[8];
#pragma unroll
        for (int c = 0; c < 4; ++c) { kf[2 * c] = *(const LAS bf16x8*)(kb + c * 32); kf[2 * c + 1] = *(const LAS bf16x8*)(kb + 32 * G::KP + c * 32); }
        p0 = MFMA32(kf[0], qf[0], cinit); p1 = MFMA32(kf[1], qf[0], cinit);
#pragma unroll
        for (int c = 1; c < 4; ++c) { p0 = MFMA32(kf[2 * c], qf[c], p0); p1 = MFMA32(kf[2 * c + 1], qf[c], p1); } };
    const int last = ntiles - 1;
    auto img = [&](int t) { return lds + (t % 5) * G::BUF; };
    auto cl = [&](int t) { return ta.tile(t < ntiles ? t : last); };
    __syncthreads();
    issueA(cl(0)); commit_(img(0), kA, vA); issueA(cl(1)); commit_(img(1), kA, vA);
    issueA(cl(2)); commit_(img(2), kA, vA);
    __syncthreads();
    f32x16 s0, s1;
    qk(img(0), s0, s1);
    auto body = [&](int t, int offV, int offK) {
        f32x16 n0, n1;
        qk(lds + offK, n0, n1);
        const bool on = (t < ntiles) && ta.on(ta.tile(t < ntiles ? t : last));
        float ps = 0.f;
#pragma unroll
        for (int r = 0; r < 16; ++r) { s0[r] = fexp2(s0[r]); s1[r] = fexp2(s1[r]); ps += s0[r] + s1[r]; }
        l_run += on ? ps : 0.f;
        bf16x8 pf[2][2];
#pragma unroll
        for (int s = 0; s < 2; ++s) {
            u32x4 w0, w1;
            w0.x = pk2(s0[8 * s + 0], s0[8 * s + 1]); w0.y = pk2(s0[8 * s + 2], s0[8 * s + 3]); w0.z = pk2(s0[8 * s + 4], s0[8 * s + 5]); w0.w = pk2(s0[8 * s + 6], s0[8 * s + 7]);
            w1.x = pk2(s1[8 * s + 0], s1[8 * s + 1]); w1.y = pk2(s1[8 * s + 2], s1[8 * s + 3]); w1.z = pk2(s1[8 * s + 4], s1[8 * s + 5]); w1.w = pk2(s1[8 * s + 6], s1[8 * s + 7]);
            if (!on) { w0 = (u32x4){0u, 0u, 0u, 0u}; w1 = (u32x4){0u, 0u, 0u, 0u}; }
            pf[0][s] = __builtin_bit_cast(bf16x8, w0); pf[1][s] = __builtin_bit_cast(bf16x8, w1);
        }
        const LAS unsigned char* vb = lds + offV + G::KT + c32 * G::VP + hi * 16;
        bf16x8 vf[2][2][2];
#pragma unroll
        for (int db = 0; db < 2; ++db)
#pragma unroll
            for (int kh = 0; kh < 2; ++kh)
#pragma unroll
                for (int s = 0; s < 2; ++s) vf[db][kh][s] = *(const LAS bf16x8*)(vb + db * 32 * G::VP + kh * 64 + s * 32);
#pragma unroll
        for (int kh = 0; kh < 2; ++kh)
#pragma unroll
            for (int s = 0; s < 2; ++s)
#pragma unroll
                for (int db = 0; db < 2; ++db) o[db] = MFMA32(vf[db][kh][s], pf[kh][s], o[db]);
        s0 = n0; s1 = n1; };
    int o0 = 0, o1 = G::BUF, o2 = 2 * G::BUF, o3 = 3 * G::BUF, o4 = 4 * G::BUF;
    for (int t = 0; t < ntiles; t += 2) {
        issueA(cl(t + 3));
        body(t, o0, o1);
        commit_(lds + o3, kA, vA);
        __builtin_amdgcn_sched_barrier(0);
        issueA(cl(t + 4));
        body(t + 1, o1, o2);
        commit_(lds + o4, kA, vA);
        __syncthreads();
        { const int a = o0, b = o1; o0 = o2; o1 = o3; o2 = o4; o3 = a; o4 = b; }
    }
}

struct TaSlc {
    const bf16_t* K; const bf16_t* VT; int b, g, qb, qi, hi; unsigned long long sel; int t0;
    DI int tile(int i) const { return t0 + i; }
    DI bool on(int tile) const { return (sel >> tile) & 1ull; }
    DI const bf16_t* kptr(int tile, int row, int ch) const { return K + (((size_t)b * 4096 + 64 * tile + row) * 2 + g) * 64 + ch * 8; }
    DI const bf16_t* vptr(int tile, int d, int ch) const { return VT + ((size_t)(b * 2 + g) * 64 + d) * 4096 + 64 * tile + ch * 8; }
    DI void mask(int tile, f32x16& p0, f32x16& p1) const {
        const bool on = (sel >> tile) & 1ull;
        if (!on) {
#pragma unroll
            for (int r = 0; r < 16; ++r) { p0[r] = -INFINITY; p1[r] = -INFINITY; }
        } else if (tile == qb) {
#pragma unroll
            for (int r = 0; r < 16; ++r) { const int k = crow(r, hi); if (k > qi) p0[r] = -INFINITY; if (k + 32 > qi) p1[r] = -INFINITY; }
        }
    }
};
struct TaWin {
    const bf16_t* K; const bf16_t* VT; int b, g, qb, qi, hi; int t0;
    DI int tile(int i) const { return t0 - i; }
    DI bool on(int) const { return true; }
    DI const bf16_t* kptr(int tile, int row, int ch) const { return K + (((size_t)b * 4096 + 64 * tile + row) * 2 + g) * 64 + ch * 8; }
    DI const bf16_t* vptr(int tile, int d, int ch) const { return VT + ((size_t)(b * 2 + g) * 64 + d) * 4096 + 64 * tile + ch * 8; }
    DI void mask(int tile, f32x16& p0, f32x16& p1) const {
        if (tile == qb) {
#pragma unroll
            for (int r = 0; r < 16; ++r) { const int k = crow(r, hi); if (k > qi) p0[r] = -INFINITY; if (k + 32 > qi) p1[r] = -INFINITY; }
        } else if (tile == qb - 8) {
#pragma unroll
            for (int r = 0; r < 16; ++r) { const int k = crow(r, hi); if (k <= qi) p0[r] = -INFINITY; if (k + 32 <= qi) p1[r] = -INFINITY; }
        }
    }
};
DI void nsa_unit(const Params& P, int l, int b, int g, int qb, LAS unsigned char* lds, const unsigned long long sel) {
    const int tid = ltid(), wid = __builtin_amdgcn_readfirstlane(tid >> 6), lane = tid & 63, c32 = lane & 31, hi = lane >> 5;
    const int qi = 8 * wid + (c32 >> 2), head = 4 * g + (c32 & 3); const size_t m = (size_t)b * 4096 + 64 * qb + qi;
    bf16x8 qf[4];
    { const bf16_t* qp = (const bf16_t*)(P.ws + WS_QR) + m * 512 + head * 64 + 8 * hi;
#pragma unroll
      for (int c = 0; c < 4; ++c) qf[c] = *(const bf16x8*)(qp + 16 * c); }
    f32x16 os[2], ow[2];
    float ls, lw;
    float gq = fabsf(P.q_norm[l * 64 + lane]), gs = fabsf(P.k_norm[(l * 3 + 1) * 64 + lane]), gw = fabsf(P.k_norm[(l * 3 + 2) * 64 + lane]);
#pragma unroll
    for (int o_ = 1; o_ < 64; o_ <<= 1) { gq = fmaxf(gq, __shfl_xor(gq, o_)); gs = fmaxf(gs, __shfl_xor(gs, o_)); gw = fmaxf(gw, __shfl_xor(gw, o_)); }
    const float nbs = -(64.0f * C2 * 1.02f) * gq * gs, nbw = -(64.0f * C2 * 1.02f) * gq * gw;
    { os[0] = f32x16{}; os[1] = f32x16{}; ls = 0.f;
      TaSlc ta{(const bf16_t*)(P.ws + WS_KS), (const bf16_t*)(P.ws + WS_VST), b, g, qb, qi, hi, sel, 0};
      f32x16 cv;
#pragma unroll
      for (int r = 0; r < 16; ++r) cv[r] = nbs;
      flash_pass_pipe(lds, qf, os, ls, qb, ta, cv);
      TaSlc td{(const bf16_t*)(P.ws + WS_KS), (const bf16_t*)(P.ws + WS_VST), b, g, qb, qi, hi, sel, qb};
      flash_pass<64, 64>(lds, qf, os, ls, 1, td, nbs); }
    { ow[0] = f32x16{}; ow[1] = f32x16{}; lw = 0.f;
      TaWin td{(const bf16_t*)(P.ws + WS_KW), (const bf16_t*)(P.ws + WS_VWT), b, g, qb, qi, hi, qb};
      flash_pass<64, 64>(lds, qf, ow, lw, 1, td, nbw);
      TaWin tm{(const bf16_t*)(P.ws + WS_KW), (const bf16_t*)(P.ws + WS_VWT), b, g, qb, qi, hi, qb - 1};
      f32x16 cv;
#pragma unroll
      for (int r = 0; r < 16; ++r) cv[r] = nbw;
      flash_pass_pipe(lds, qf, ow, lw, qb < 7 ? qb : 7, tm, cv);
      if (qb >= 8) { TaWin te{(const bf16_t*)(P.ws + WS_KW), (const bf16_t*)(P.ws + WS_VWT), b, g, qb, qi, hi, qb - 8};
          flash_pass<64, 64>(lds, qf, ow, lw, 1, te, nbw); } }
    ls += __shfl_xor(ls, 32); lw += __shfl_xor(lw, 32);
    const bf16_t* Hr = (const bf16_t*)(P.ws + WS_H) + m * LDH + HNG;
    const float g0 = bf2f(Hr[head]), g1 = bf2f(Hr[8 + head]) * frcp(ls), g2 = bf2f(Hr[16 + head]) * frcp(lw);
    const LAS u32x2* ocs = (const LAS u32x2*)(lds + OC_STASH) + wid * 64 + lane;
    bf16_t* brp = (bf16_t*)(P.ws + WS_BR) + m * 1536 + head * 64;
#pragma unroll
    for (int db = 0; db < 2; ++db)
#pragma unroll
        for (int rg = 0; rg < 4; ++rg) { const int d = 32 * db + 8 * rg + 4 * hi; const u32x2 oc = ocs[(db * 4 + rg) * 512];
            const float v0 = g0 * bflo(oc.x) + g1 * os[db][4 * rg + 0] + g2 * ow[db][4 * rg + 0], v1 = g0 * bfhi(oc.x) + g1 * os[db][4 * rg + 1] + g2 * ow[db][4 * rg + 1];
            const float v2 = g0 * bflo(oc.y) + g1 * os[db][4 * rg + 2] + g2 * ow[db][4 * rg + 2], v3 = g0 * bfhi(oc.y) + g1 * os[db][4 * rg + 3] + g2 * ow[db][4 * rg + 3];
            u32x2 w; w.x = pk2(v0, v1); w.y = pk2(v2, v3); *(u32x2*)(brp + d) = w; }
}

struct TaMem {
    const bf16_t* K; const bf16_t* VT;
    DI int tile(int i) const { return i; }
    DI const bf16_t* kptr(int tile, int row, int ch) const { return K + (size_t)(64 * tile + row) * 128 + ch * 8; }
    DI const bf16_t* vptr(int tile, int d, int ch) const { return VT + (size_t)d * 256 + 64 * tile + ch * 8; }
    DI void mask(int, f32x16&, f32x16&) const {}
};
DI void mem_unit(const Params& P, int l, int b, int h, int qblk, LAS unsigned char* lds) {
    const int tid = ltid(), wid = __builtin_amdgcn_readfirstlane(tid >> 6), lane = tid & 63, c32 = lane & 31, hi = lane >> 5;
    const size_t m = (size_t)b * 4096 + 256 * qblk + 32 * wid + c32;
    bf16x8 qf[8];
    { const bf16_t* qp = (const bf16_t*)(P.ws + WS_MQ) + m * 512 + h * 128 + 8 * hi;
#pragma unroll
      for (int c = 0; c < 8; ++c) qf[c] = *(const bf16x8*)(qp + 16 * c); }
    const size_t hb = ((size_t)l * 4 + b) * 4 + h;
    bf16_t* brp = (bf16_t*)(P.ws + WS_BR) + m * 1536 + 1024 + h * 128;
    float gq = fmaxf(fabsf(P.mem_q_norm[l * 128 + lane]), fabsf(P.mem_q_norm[l * 128 + 64 + lane])), gk = fmaxf(fabsf(P.mem_k_norm[l * 128 + lane]), fabsf(P.mem_k_norm[l * 128 + 64 + lane]));
#pragma unroll
    for (int o_ = 1; o_ < 64; o_ <<= 1) { gq = fmaxf(gq, __shfl_xor(gq, o_)); gk = fmaxf(gk, __shfl_xor(gk, o_)); }
    const float nbm = -(128.0f * C2M * 1.02f) * gq * gk;
#pragma unroll 1
    for (int half = 0; half < 2; ++half) {
        f32x16 o[2]; o[0] = f32x16{}; o[1] = f32x16{};
        float ll = 0.f;
        TaMem ta{(const bf16_t*)(P.ws + WS_MK) + hb * 256 * 128, (const bf16_t*)(P.ws + WS_MVT) + hb * 128 * 256 + (size_t)half * 64 * 256};
        flash_pass<128, 64>(lds, qf, o, ll, 4, ta, nbm);
        ll += __shfl_xor(ll, 32); const float il = frcp(ll);
#pragma unroll
        for (int db = 0; db < 2; ++db)
#pragma unroll
            for (int rg = 0; rg < 4; ++rg) { const int d = 64 * half + 32 * db + 8 * rg + 4 * hi;
                u32x2 w; w.x = pk2(o[db][4 * rg] * il, o[db][4 * rg + 1] * il); w.y = pk2(o[db][4 * rg + 2] * il, o[db][4 * rg + 3] * il); *(u32x2*)(brp + d) = w; }
    }
}

constexpr int CA_KP = 144, CA_VP = 520, CA_K = 0, CA_V = 36864, CA_S = 36864 + 33280;
DI unsigned long long cmp_unit(const Params& P, int b, int g, int qb, LAS unsigned char* lds) {
    const int tid = ltid(), wid = __builtin_amdgcn_readfirstlane(tid >> 6), lane = tid & 63, c32 = lane & 31, hi = lane >> 5;
    const int qi = 8 * wid + (c32 >> 2), head = 4 * g + (c32 & 3), t = 64 * qb + qi; const size_t m = (size_t)b * 4096 + t;
    const int nkt = (4 * qb + 3 + 31) >> 5;
    __syncthreads();
    { const bf16_t* KC = (const bf16_t*)(P.ws + WS_KC) + (size_t)(b * 2 + g) * 256 * 64; const bf16_t* VCT = (const bf16_t*)(P.ws + WS_VCT) + (size_t)(b * 2 + g) * 64 * 256;
      u32x4 kr[4], vr[4];
#pragma unroll
      for (int i = 0; i < 4; ++i) { const int id = tid + i * 512; kr[i] = *(const u32x4*)(KC + (size_t)(id >> 3) * 64 + (id & 7) * 8); vr[i] = *(const u32x4*)(VCT + (size_t)(id >> 5) * 256 + (id & 31) * 8); }
      asm volatile("" : "+v"(kr[0]), "+v"(kr[1]), "+v"(kr[2]), "+v"(kr[3]), "+v"(vr[0]), "+v"(vr[1]), "+v"(vr[2]), "+v"(vr[3]));
#pragma unroll
      for (int i = 0; i < 4; ++i) { const int id = tid + i * 512;
          *(LAS u32x4*)(lds + CA_K + (id >> 3) * CA_KP + (id & 7) * 16) = kr[i];
          LAS unsigned char* vp = lds + CA_V + (id >> 5) * CA_VP + (id & 31) * 16;
          *(LAS u32x2*)vp = (u32x2){vr[i].x, vr[i].y}; *(LAS u32x2*)(vp + 8) = (u32x2){vr[i].z, vr[i].w}; } }
    bf16x8 qf[4];
    { const bf16_t* qp = (const bf16_t*)(P.ws + WS_QC) + m * 512 + head * 64 + 8 * hi;
#pragma unroll
      for (int c = 0; c < 4; ++c) qf[c] = *(const bf16x8*)(qp + 16 * c); }
    __syncthreads();
    const int lim = (t - 31) >> 4;
    f32x16 sc[8];
    float mx = -INFINITY;
#pragma unroll
    for (int kt = 0; kt < 8; ++kt) {
        sc[kt] = f32x16{};
        if (kt < nkt) {
            const LAS unsigned char* kb = lds + CA_K + (32 * kt + c32) * CA_KP + hi * 16;
#pragma unroll
            for (int c = 0; c < 4; ++c) sc[kt] = MFMA32(*(const LAS bf16x8*)(kb + c * 32), qf[c], sc[kt]);
#pragma unroll
            for (int r = 0; r < 16; ++r) { const int i = 32 * kt + crow(r, hi); if (i > lim) sc[kt][r] = -INFINITY; mx = fmaxf(mx, sc[kt][r]); }
        }
    }
    mx = fmaxf(mx, __shfl_xor(mx, 32));
    const float mu = (mx == -INFINITY) ? 0.f : mx;
    float sum = 0.f;
#pragma unroll
    for (int kt = 0; kt < 8; ++kt) if (kt < nkt) {
#pragma unroll
        for (int r = 0; r < 16; ++r) { sc[kt][r] = fexp2(sc[kt][r] - mu); sum += sc[kt][r]; } }
    sum += __shfl_xor(sum, 32);
    const float inv = sum > 0.f ? 1.0f / sum : 0.f;
    f32x16 o[2]; o[0] = f32x16{}; o[1] = f32x16{};
    float sa[8][4], se[8][4];
#pragma unroll
    for (int kt = 0; kt < 8; ++kt)
#pragma unroll
        for (int rg = 0; rg < 4; ++rg) { sa[kt][rg] = 0.f; se[kt][rg] = 0.f; }
#pragma unroll
    for (int kt = 0; kt < 8; ++kt) if (kt < nkt) {
#pragma unroll
        for (int r = 0; r < 16; ++r) sc[kt][r] *= inv;
#pragma unroll
        for (int rg = 0; rg < 4; ++rg) { sa[kt][rg] = (sc[kt][4 * rg] + sc[kt][4 * rg + 1]) + (sc[kt][4 * rg + 2] + sc[kt][4 * rg + 3]); se[kt][rg] = sc[kt][4 * rg + 3]; }
        const LAS unsigned char* vb = lds + CA_V + c32 * CA_VP + kt * 64 + hi * 8;
#pragma unroll
        for (int s = 0; s < 2; ++s) { u32x4 w; w.x = pk2(sc[kt][8 * s + 0], sc[kt][8 * s + 1]); w.y = pk2(sc[kt][8 * s + 2], sc[kt][8 * s + 3]); w.z = pk2(sc[kt][8 * s + 4], sc[kt][8 * s + 5]); w.w = pk2(sc[kt][8 * s + 6], sc[kt][8 * s + 7]);
            const bf16x8 pf = __builtin_bit_cast(bf16x8, w);
#pragma unroll
            for (int db = 0; db < 2; ++db) { const LAS unsigned char* vp = vb + db * 32 * CA_VP + s * 32;
                const s16x4 lo = *(const LAS s16x4*)vp, hh = *(const LAS s16x4*)(vp + 16);
                o[db] = MFMA32(__builtin_shufflevector(lo, hh, 0, 1, 2, 3, 4, 5, 6, 7), pf, o[db]); } } }
    { LAS u32x2* ocs = (LAS u32x2*)(lds + OC_STASH) + wid * 64 + lane;
#pragma unroll
      for (int db = 0; db < 2; ++db)
#pragma unroll
          for (int rg = 0; rg < 4; ++rg) { u32x2 w; w.x = pk2(o[db][4 * rg], o[db][4 * rg + 1]); w.y = pk2(o[db][4 * rg + 2], o[db][4 * rg + 3]); ocs[(db * 4 + rg) * 512] = w; } }
    unsigned long long mask;
    if (qb < 16) mask = (2ull << qb) - 1ull;
    else {
        LAS float* scl = (LAS float*)(lds + CA_S) + wid * 576 + (c32 >> 2) * 72;
        float prevx = 0.f;
#pragma unroll
        for (int kt = 0; kt < 8; ++kt)
#pragma unroll
            for (int rg = 0; rg < 4; ++rg) {
                const float a = sa[kt][rg], e = se[kt][rg];
                const float x = __shfl_xor(e, 32);
                float sp = a + (hi ? x : prevx);
                prevx = x;
                sp += __shfl_xor(sp, 1); sp += __shfl_xor(sp, 2);
                const int j = 8 * kt + 2 * rg + hi;
                if ((c32 & 3) == 0) scl[j] = (j >= 1 && j <= qb - 2) ? __uint_as_float(((__float_as_uint(sp) & ~63u) | (unsigned)(63 - j)) + 64u) : __uint_as_float(0u);
            }
        LDS_WAIT();
        const int sub = (lane & 3) | (hi << 2);
        unsigned own[8]; int cnt[8];
        const LAS unsigned* sclu = (const LAS unsigned*)scl;
#pragma unroll
        for (int s = 0; s < 8; ++s) { own[s] = sclu[8 * s + sub]; cnt[s] = 0; }
        for (int jj = 0; jj < 64; ++jj) { const unsigned v = sclu[jj];
#pragma unroll
            for (int s = 0; s < 8; ++s) cnt[s] += (v > own[s]) ? 1 : 0; }
        mask = 0ull; const int sh = 4 * (c32 >> 2);
#pragma unroll
        for (int s = 0; s < 8; ++s) { const unsigned long long bl = __ballot(own[s] != 0u && cnt[s] < 13);
            const unsigned long long byte = ((bl >> sh) & 0xFull) | (((bl >> (32 + sh)) & 0xFull) << 4); mask |= byte << (8 * s); }
        mask |= 1ull | (1ull << qb) | (1ull << (qb - 1));
    }
    return mask;
}
template <int HDIM, int NHQ, class KF, class VF, class MF>
DI void lds_attn(LAS unsigned char* stg, const LAS float* qs, LAS float* sb, int smax, LAS float* invs, LAS float* part, LAS float* ob, int nkeys, const KF& kf, const VF& vf, const MF& valid) {
    constexpr int CH = (HDIM == 64) ? 512 : 256, KP = HDIM * 2 + 16, VP = HDIM * 2, CPR = HDIM / 4  , NLD = CH * CPR / 512;
    constexpr int PAIRS = CH * NHQ, PPT = PAIRS >= 512 ? PAIRS / 512 : 1, SPLIT = PAIRS >= 512 ? 1 : 512 / PAIRS, DPT = HDIM / SPLIT, QP = HDIM + 4  ;
    const int tid = ltid(), wid = tid >> 6, lane = tid & 63;
    const bool two = nkeys > CH;
    f32x4 bA[NLD], bB[NLD];
    const int row0 = tid / CPR, cc0 = tid % CPR;
#define LA_ISSUE(bank, fn, c) do { _Pragma("unroll") for (int i_ = 0; i_ < NLD; ++i_) { const int key_ = (c) * CH + row0 + i_ * (512 / CPR); bank[i_] = (key_ < nkeys) ? ((const f32x4*)fn(key_))[cc0] : (f32x4){0.f, 0.f, 0.f, 0.f}; } } while (0)
#define LA_COMMIT(bank, pitch) do { LAS unsigned char* wb_ = stg + row0 * (pitch) + cc0 * 8; _Pragma("unroll") for (int i_ = 0; i_ < NLD; ++i_) { u32x2 w_; w_.x = pk2(bank[i_].x, bank[i_].y); w_.y = pk2(bank[i_].z, bank[i_].w); *(LAS u32x2*)(wb_ + i_ * (512 / CPR) * (pitch)) = w_; } } while (0)
    auto scores = [&](int c) {
        const int pr0 = (SPLIT == 1) ? tid : tid / SPLIT, h = pr0 % NHQ, sp = (SPLIT == 1) ? 0 : tid % SPLIT;
        const LAS unsigned char* kr = stg + (pr0 / NHQ) * KP + sp * DPT * 2; const LAS float* qp = qs + h * QP + sp * DPT; float a[PPT];
#pragma unroll
        for (int j = 0; j < PPT; ++j) a[j] = 0.f;
#pragma unroll 2
        for (int d = 0; d < DPT; d += 8) { const f32x4 q0 = *(const LAS f32x4*)(qp + d), q1 = *(const LAS f32x4*)(qp + d + 4);
#pragma unroll
            for (int j = 0; j < PPT; ++j) { float kv[8]; unpack8(*(const LAS u32x4*)(kr + j * (512 / NHQ) * KP + d * 2), kv);
                a[j] += (kv[0] * q0.x + kv[1] * q0.y) + (kv[2] * q0.z + kv[3] * q0.w) + (kv[4] * q1.x + kv[5] * q1.y) + (kv[6] * q1.z + kv[7] * q1.w); } }
#pragma unroll
        for (int j = 0; j < PPT; ++j) { float aj = a[j]; const int key = c * CH + pr0 / NHQ + j * (512 / NHQ);
            if (SPLIT > 1) {
#pragma unroll
                for (int o = 1; o < SPLIT; o <<= 1) aj += __shfl_xor(aj, o); }
            if (key < nkeys && sp == 0) sb[h * smax + key] = valid(key) ? aj : -INFINITY; } };
    constexpr int LPP = NHQ * HDIM / 4, NP = 512 / LPP, KPP = CH / NP;
    const int pp = tid / LPP, w = tid % LPP, h = w / (HDIM / 4), d4 = w % (HDIM / 4); f32x4 acc = {0.f, 0.f, 0.f, 0.f};
    auto pv = [&](int c) {
        const int k0 = c * CH + pp * KPP; const LAS unsigned char* vr = stg + pp * KPP * VP + d4 * 8; const LAS float* pr = sb + h * smax + k0;
#pragma unroll 4
        for (int kk = 0; kk < KPP; kk += 4) { if (k0 + kk < nkeys) { f32x4 p4 = *(const LAS f32x4*)(pr + kk);
            if (k0 + kk + 3 >= nkeys) { if (k0 + kk + 1 >= nkeys) p4.y = 0.f; if (k0 + kk + 2 >= nkeys) p4.z = 0.f; p4.w = 0.f; }
            const float pe[4] = {p4.x, p4.y, p4.z, p4.w};
#pragma unroll
            for (int e = 0; e < 4; ++e) { const u32x2 vv = *(const LAS u32x2*)(vr + (kk + e) * VP); const float p = pe[e];
                acc.x += p * bflo(vv.x); acc.y += p * bfhi(vv.x); acc.z += p * bflo(vv.y); acc.w += p * bfhi(vv.y); } } } };
    LA_ISSUE(bA, kf, 0);
    if (two) LA_ISSUE(bB, kf, 1); else LA_ISSUE(bB, vf, 0);
    __syncthreads();
    LA_COMMIT(bA, KP);
    if (two) LA_ISSUE(bA, vf, 0);
    __syncthreads();
    scores(0);
    if (two) { __syncthreads(); LA_COMMIT(bB, KP); LA_ISSUE(bB, vf, 1); __syncthreads(); scores(1); }
    __syncthreads();
    if (wid < NHQ) { LAS float* sr = sb + wid * smax; float mx = -INFINITY;
        for (int k = lane; k < nkeys; k += 64) mx = fmaxf(mx, sr[k]);
#pragma unroll
        for (int o = 1; o < 64; o <<= 1) mx = fmaxf(mx, __shfl_xor(mx, o));
        float sum = 0.f;
        for (int k = lane; k < nkeys; k += 64) { const float e = fexp2(sr[k] - mx); sr[k] = e; sum += e; }
        sum = wave_sum(sum);
        if (lane == 0) invs[wid] = 1.0f / sum; }
    if (two) { LA_COMMIT(bA, VP); __syncthreads(); pv(0); __syncthreads(); LA_COMMIT(bB, VP); __syncthreads(); pv(1); }
    else { LA_COMMIT(bB, VP); __syncthreads(); pv(0); }
#undef LA_ISSUE
#undef LA_COMMIT
    *(LAS f32x4*)(part + (size_t)tid * 4) = acc;
    __syncthreads();
    if (tid < NHQ * HDIM) { const int hh = tid / HDIM, d = tid % HDIM; float s2 = 0.f;
#pragma unroll
        for (int q = 0; q < NP; ++q) s2 += part[(q * LPP + hh * (HDIM / 4) + (d >> 2)) * 4 + (d & 3)];
        ob[tid] = s2 * invs[hh]; }
    __syncthreads();
}
DI void sample_nsa_unit(const Params& P, int l, int b, int g, LAS unsigned char* lds) {
    const int tid = ltid();
    LAS float* qs_c = (LAS float*)(lds + 73728); LAS float* qs_r = qs_c + 272; LAS float* sb = qs_r + 272; LAS float* invs = sb + 4160; LAS float* part = invs + 8;
    LAS float* ob_c = part + 2048; LAS float* ob_s = ob_c + 256; LAS float* ob_w = ob_s + 256; LAS float* imp = ob_w + 256; LAS float* scj = imp + 512; LAS int* flag = (LAS int*)(scj + 160); LAS int* sl = flag + 160; LAS unsigned long long* kbase = (LAS unsigned long long*)(sl + 16);
    const size_t m = (size_t)MP + b;
    __syncthreads();
    if (tid < 256) { const int h = tid >> 6, d = tid & 63; qs_c[h * 68 + d] = bf2f(((const bf16_t*)(P.ws + WS_QC))[m * 512 + (4 * g + h) * 64 + d]); qs_r[h * 68 + d] = bf2f(((const bf16_t*)(P.ws + WS_QR))[m * 512 + (4 * g + h) * 64 + d]); }
    __syncthreads();
    { const float* KCb = (const float*)(P.ws + WS_KCS) + ((size_t)(l * 32 + b) * 2 + g) * 512 * 64; const float* VCb = (const float*)(P.ws + WS_VCS) + ((size_t)(l * 32 + b) * 2 + g) * 512 * 64;
      auto kf = [&](int key) { return KCb + (size_t)key * 64; }; auto vf = [&](int key) { return VCb + (size_t)key * 64; }; auto va = [&](int) { return true; };
      lds_attn<64, 4>(lds, qs_c, sb, 1040, invs, part, ob_c, 511, kf, vf, va); }
    for (int i = tid; i < 512; i += 512) imp[i] = (i < 511) ? (sb[i] * invs[0] + sb[1040 + i] * invs[1]) + (sb[2080 + i] * invs[2] + sb[3120 + i] * invs[3]) : 0.f;
    __syncthreads();
    if (tid < 129) { float s = 0.f;
#pragma unroll
        for (int q = -1; q < 4; ++q) { const int i = 4 * tid + q; if (i >= 0 && i < 511) s += imp[i]; }
        scj[tid] = s; }
    __syncthreads();
    if (tid < 129) { int f = 0;
        if (tid == 0 || tid >= 127) f = 1;
        else { const float mine = scj[tid]; int cnt = 0;
            for (int j = 1; j <= 126; ++j) { const float v = scj[j]; cnt += ((v > mine) || (v == mine && j < tid)) ? 1 : 0; }
            f = cnt < 13; }
        flag[tid] = f; }
    __syncthreads();
    if (tid < 64) { const int f0 = flag[tid], f1 = flag[64 + tid];
        const unsigned long long b0 = __ballot(f0), b1 = __ballot(f1), lt = (1ull << tid) - 1ull;
        if (tid < 16) sl[tid] = 128;
        const int p0 = __popcll(b0 & lt), p1 = __popcll(b0) + __popcll(b1 & lt);
        if (f0 && p0 < 16) sl[p0] = tid;
        if (f1 && p1 < 16) sl[p1] = 64 + tid; }
    __syncthreads();
    if (tid < 16) { const int kp0 = 64 * sl[tid]; const int* pt = P.page_table + b * 64;
        kbase[tid] = (kp0 < PAST) ? ((unsigned long long)pt[kp0 >> 7] * 128 + (unsigned)(kp0 & 127)) * 512ull : ~0ull; }
    __syncthreads();
    { const float* cache = P.cache_nsa + (size_t)l * NPHYS * (128 * 512);
      const float* newrow = P.out + O_ROWSS + ((size_t)l * 32 + b) * 512;
      auto kpos = [&](int key) { return 64 * sl[key >> 6] + (key & 63); };
      auto kf = [&](int key) { const unsigned long long o = kbase[key >> 6]; return (o != ~0ull) ? cache + (size_t)o + (size_t)(key & 63) * 512 + 2 * 128 + g * 64 : newrow + 2 * 128 + g * 64; };
      auto vf = [&](int key) { const unsigned long long o = kbase[key >> 6]; return (o != ~0ull) ? cache + (size_t)o + (size_t)(key & 63) * 512 + 3 * 128 + g * 64 : newrow + 3 * 128 + g * 64; };
      auto va = [&](int key) { return kpos(key) <= PAST; };
      lds_attn<64, 4>(lds, qs_r, sb, 1040, invs, part, ob_s, 1024, kf, vf, va); }
    if (tid < 256) { const int h = tid >> 6, d = tid & 63, head = 4 * g + h; float* so = (float*)(P.ws + WS_SOUT) + (size_t)b * 1536 + head * 64 + d; so[0] = ob_c[tid]; so[512] = ob_s[tid]; }
}
DI void sample_win_unit(const Params& P, int l, int b, int g, LAS unsigned char* lds) {
    const int tid = ltid();
    LAS float* qs_r = (LAS float*)(lds + 73728); LAS float* sb = qs_r + 272; LAS float* invs = sb + 4160; LAS float* part = invs + 8; LAS float* ob_w = part + 2048;
    const size_t m = (size_t)MP + b;
    __syncthreads();
    if (tid < 256) { const int h = tid >> 6, d = tid & 63; qs_r[h * 68 + d] = bf2f(((const bf16_t*)(P.ws + WS_QR))[m * 512 + (4 * g + h) * 64 + d]); }
    __syncthreads();
    const float* wb = P.out + O_WINS + ((size_t)l * 32 + b) * 512 * 256;
    auto kf = [&](int key) { return wb + (size_t)key * 256 + g * 64; }; auto vf = [&](int key) { return wb + (size_t)key * 256 + 128 + g * 64; }; auto va = [&](int) { return true; };
    lds_attn<64, 4>(lds, qs_r, sb, 1040, invs, part, ob_w, 512, kf, vf, va);
    if (tid < 256) { const int h = tid >> 6, d = tid & 63, head = 4 * g + h; ((float*)(P.ws + WS_SOUT))[(size_t)b * 1536 + 1024 + head * 64 + d] = ob_w[tid]; }
}
DI void sample_combine_row(const Params& P, int b, int lane) {
    const size_t m = (size_t)MP + b; const float* so = (const float*)(P.ws + WS_SOUT) + (size_t)b * 1536 + 8 * lane; const bf16_t* Hr = (const bf16_t*)(P.ws + WS_H) + m * LDH + HNG; const int head = lane >> 3;
    const float g0 = bf2f(Hr[head]), g1 = bf2f(Hr[8 + head]), g2 = bf2f(Hr[16 + head]); float v[8];
#pragma unroll
    for (int j = 0; j < 8; ++j) v[j] = g0 * so[j] + g1 * so[512 + j] + g2 * so[1024 + j];
    *(u32x4*)((bf16_t*)(P.ws + WS_BR) + m * 1536 + 8 * lane) = pack8(v);
}
DI void sample_mem_unit(const Params& P, int l, int b, int h, LAS unsigned char* lds) {
    const int tid = ltid();
    LAS float* qs = (LAS float*)(lds + 73728); LAS float* sb = qs + 128; LAS float* invs = sb + 256; LAS float* part = invs + 8; LAS float* ob = part + 2048;
    const size_t m = (size_t)MP + b;
    __syncthreads();
    if (tid < 128) qs[tid] = bf2f(((const bf16_t*)(P.ws + WS_MQ))[m * 512 + h * 128 + tid]);
    __syncthreads();
    const float* mk = P.cache_mem + ((size_t)l * 32 + b) * 256 * 1024 + h * 128;
    auto kf = [&](int key) { return mk + (size_t)key * 1024; }; auto vf = [&](int key) { return mk + (size_t)key * 1024 + 512; }; auto va = [&](int) { return true; };
    lds_attn<128, 1>(lds, qs, sb, 256, invs, part, ob, 256, kf, vf, va);
    if (tid < 128) ((bf16_t*)(P.ws + WS_BR))[m * 1536 + 1024 + h * 128 + tid] = (bf16_t)f2bf(ob[tid]);
}

DI void s_inproj_item(const Params& P, int l, int it, LAS unsigned char* lds) {
    const bf16_t* XB = (const bf16_t*)(P.ws + WS_XB) + (size_t)MP * 1024; const bf16_t* W = (const bf16_t*)(wl(P, l) + WL_WIN);
    auto ap = [&](int, int m, int k) { return XB + (size_t)m * 1024 + k; }; auto bp = [&](int, int n, int k) { return W + (size_t)(32 * it + n) * 1024 + k; };
    small_gemm_tile<1>(lds, 1024, ap, bp);
    const LAS float* fin = (const LAS float*)(lds + 32768); const float* ssq = (l == 0 ? (const float*)(P.ws + WS_RINV) : (const float*)(P.ws + WS_SSQ) + 2 * SSQ_STRIDE) + MP; bf16_t* H = (bf16_t*)(P.ws + WS_H) + (size_t)MP * LDH;
    for (int e = ltid(); e < 1024; e += 512) { const int m = e >> 5, n = e & 31, col = 32 * it + n; float v = fin[n * 32 + m] * rinv_of(ssq[m]); if (col >= HMG) v = sigmoidf_(v); H[(size_t)m * LDH + col] = (bf16_t)f2bf(v); }
}
DI void s_branch_item(const Params& P, int l, int it, LAS unsigned char* lds) {
    const bf16_t* BR = (const bf16_t*)(P.ws + WS_BR) + (size_t)MP * 1536; const bf16_t* W = (const bf16_t*)(wl(P, l) + WL_WBR);
    auto ap = [&](int seg, int m, int k) { return BR + (size_t)m * 1536 + seg * 512 + k; }; auto bp = [&](int seg, int n, int k) { return W + (size_t)(32 * it + n) * 1536 + seg * 512 + k; };
    small_gemm_tile<3>(lds, 512, ap, bp);
    const LAS float* fin = (const LAS float*)(lds + 3 * 32768); const bf16_t* H = (const bf16_t*)(P.ws + WS_H) + (size_t)MP * LDH + HMG; bf16_t* MG = (bf16_t*)(P.ws + WS_MG) + (size_t)MP * 1024;
    for (int e = ltid(); e < 1024; e += 512) { const int m = e >> 5, n = e & 31, col = 32 * it + n; float v = 0.f;
#pragma unroll
        for (int s = 0; s < 3; ++s) v += fin[s * 1024 + n * 32 + m] * bf2f(H[(size_t)m * LDH + s * 1024 + col]);
        MG[(size_t)m * 1024 + col] = (bf16_t)f2bf(v); }
}
DI void s_wout_item(const Params& P, int l, int it, LAS unsigned char* lds) {
    const bf16_t* MG = (const bf16_t*)(P.ws + WS_MG) + (size_t)MP * 1024; const bf16_t* W = (const bf16_t*)(wl(P, l) + WL_WOUT);
    auto ap = [&](int, int m, int k) { return MG + (size_t)m * 1024 + k; }; auto bp = [&](int, int n, int k) { return W + (size_t)(32 * it + n) * 1024 + k; };
    small_gemm_tile<1>(lds, 1024, ap, bp);
    const LAS float* fin = (const LAS float*)(lds + 32768); float* HR = (float*)(P.ws + WS_HRES) + (size_t)MP * 1024; bf16_t* HB = (bf16_t*)(P.ws + WS_HB) + (size_t)MP * 1024; float* ssq = (float*)(P.ws + WS_SSQ) + (size_t)l * SSQ_STRIDE + MP;
    for (int e = ltid(); e < 1024; e += 512) { const int m = e >> 5, n = e & 31, col = 32 * it + n; const float v = xrow_in(P, l, MP + m)[col] + fin[n * 32 + m];
        HR[(size_t)m * 1024 + col] = v; HB[(size_t)m * 1024 + col] = (bf16_t)f2bf(v); float ss = v * v;
#pragma unroll
        for (int o_ = 1; o_ < 32; o_ <<= 1) ss += __shfl_xor(ss, o_);
        if (n == 0) atomicAdd(ssq + m, ss); }
}
DI void s_gateup_item(const Params& P, int l, int it, LAS unsigned char* lds) {
    const bf16_t* HB = (const bf16_t*)(P.ws + WS_HB) + (size_t)MP * 1024; const bf16_t* W = (const bf16_t*)(wl(P, l) + WL_WGU);
    auto ap = [&](int, int m, int k) { return HB + (size_t)m * 1024 + k; };
    auto bp = [&](int, int n, int k) { const int f = 16 * it + (n & 15); return W + (size_t)((f >> 7) * 256 + (f & 127) + (n >> 4) * 128) * 1024 + k; };
    small_gemm_tile<1>(lds, 1024, ap, bp);
    const LAS float* fin = (const LAS float*)(lds + 32768); const float* ssq = (const float*)(P.ws + WS_SSQ) + (size_t)l * SSQ_STRIDE + MP; bf16_t* ACT = (bf16_t*)(P.ws + WS_ACT) + (size_t)MP * D_FF;
    { const int e = ltid(), m = e >> 4, j = e & 15; const float ri = rinv_of(ssq[m]), gg = fin[j * 32 + m] * ri, uu = fin[(16 + j) * 32 + m] * ri; ACT[(size_t)m * D_FF + 16 * it + j] = (bf16_t)f2bf(gg * sigmoidf_(gg) * uu); }
}
DI void s_down_item(const Params& P, int l, int it, LAS unsigned char* lds) {
    const bf16_t* ACT = (const bf16_t*)(P.ws + WS_ACT) + (size_t)MP * D_FF; const bf16_t* W = (const bf16_t*)(wl(P, l) + WL_WDN);
    auto ap = [&](int, int m, int k) { return ACT + (size_t)m * D_FF + k; }; auto bp = [&](int, int n, int k) { return W + (size_t)(32 * it + n) * D_FF + k; };
    small_gemm_tile<1>(lds, D_FF, ap, bp);
    const LAS float* fin = (const LAS float*)(lds + 32768); const float* HR = (const float*)(P.ws + WS_HRES) + (size_t)MP * 1024;
    float* O = (l == 0) ? (float*)(P.ws + WS_XNEXT) + (size_t)MP * 1024 : P.out + O_YS;
    bf16_t* XB = (bf16_t*)(P.ws + WS_XB) + (size_t)MP * 1024; float* ssq = (float*)(P.ws + WS_SSQ) + 2 * SSQ_STRIDE + MP;
    for (int e = ltid(); e < 1024; e += 512) { const int m = e >> 5, n = e & 31, col = 32 * it + n; const float v = HR[(size_t)m * 1024 + col] + fin[n * 32 + m]; O[(size_t)m * 1024 + col] = v;
        if (l == 0) { XB[(size_t)m * 1024 + col] = (bf16_t)f2bf(v); float ss = v * v;
#pragma unroll
            for (int o_ = 1; o_ < 32; o_ <<= 1) ss += __shfl_xor(ss, o_);
            if (n == 0) atomicAdd(ssq + m, ss); } }
}
#ifndef N_LAUNCH_MODE
#define N_LAUNCH_MODE 0
#endif
constexpr int NPHASE = 20;
#ifndef PROBE_SITE
#define PROBE_SITE (-1)
#endif
#ifndef PROBE_MASK
#define PROBE_MASK 0
#endif
#define REPS(site) ((PROBE_SITE == (site) || ((PROBE_MASK >> (site)) & 1)) ? 2 : 1)
#ifndef PROBE_SUB
#define PROBE_SUB (-1)
#endif
#define SUBREPS(k) (PROBE_SUB == (k) ? 3 : 1)
struct SchedU { int G, c; DI bool next(int i, pg8::Unit& u) const { const long L = (long)i * G + c; if (L >= 512) return false; const int gi = (int)(L >> 7); u.grp = gi; u.pm = (int)(L & 127); u.pn = 0; u.kb = 0;
    u.aoff = (size_t)gi * ((size_t)32768 * 1024 * 2) + (size_t)u.pm * (256 * 1024 * 2); u.boff = (size_t)(gi >> 1) * WL_SIZE + (size_t)(gi & 1) * (256 * 1024 * 2); return true; } };
template <unsigned MASK> __global__ void __launch_bounds__(512, 2) mega(Params P) {
    extern __shared__ __attribute__((aligned(16))) unsigned char lds_raw[];
    LAS unsigned char* lds = (LAS unsigned char*)lds_raw;
    volatile LAS unsigned* MISC = (volatile LAS unsigned*)(lds + LDS_MISC);
    if (threadIdx.x < 64) MISC[threadIdx.x] = 0u;
    __syncthreads();
    XcdBarrier bar = xcd_barrier_post((unsigned*)(P.ws + WS_CTL) + 1024 + (size_t)P.li * XCD_BAR_WORDS, MISC + 8);
#define INW(k) (P.ph_lo <= (k) && (k) < P.ph_hi)
#define RUN(site, k) (((MASK >> (site)) & 1u) && INW(k))
#define SEAM(k) do { if (MASK == 0x7FFu && INW(k) && INW((k) + 1)) xcd_barrier(bar); } while (0)
    if (RUN(0, 0)) for (int rep_ = 0; rep_ < REPS(0); ++rep_) { if (rep_) xcd_barrier(bar); const Frame F = mk_frame(lds); phase_pa(P, F); }
    SEAM(0);
    if (RUN(1, 1)) for (int rep_ = 0; rep_ < REPS(1); ++rep_) { if (rep_) xcd_barrier(bar); const Frame F = mk_frame(lds);
        for (int it = F.gw; it < 4; it += F.ngw) { const float* cp = (const float*)(wl(P, it >> 1) + WL_CBP) + (it & 1) * 1024; float* cf = (float*)(wl(P, it >> 1) + WL_CBF) + (it & 1) * 128;
            float a0 = 0.f, a1 = 0.f;
#pragma unroll
            for (int q = 0; q < 8; ++q) { a0 += cp[q * 128 + F.lane]; a1 += cp[q * 128 + 64 + F.lane]; }
            cf[F.lane] = a0; cf[64 + F.lane] = a1; }
        { pg8::Gemm g{(const bf16_t*)(P.ws + WS_MEMB), (const bf16_t*)(P.ws + WS_W + WL_WMEM), 1024, 1024, 1024};
          pg8::SchedGroups S{4, 4, 2, F.G, F.G - 1 - F.cu, (size_t)256 * 1024 * 2, (size_t)256 * 1024 * 2, 0, WL_SIZE};
          EpiScaleF32 E{(float*)(P.ws + WS_MKVRAW), (size_t)1024 * 1024, 1024, (const float*)(P.ws + WS_RINVM)};
          pg8::gemm_phase(lds, g, S, E); }
        { volatile LAS int* qw = (volatile LAS int*)(lds + LDS_MISC + 64);
          unsigned* head = (unsigned*)(P.ws + WS_QUEUE) + 64 * rep_;
          for (;;) {
              __syncthreads();
              if (F.tid == 0) qw[0] = (int)__hip_atomic_fetch_add(head, 1u, __ATOMIC_RELAXED, __HIP_MEMORY_SCOPE_AGENT);
              __syncthreads();
              const int u = qw[0];
              if (u >= 1152) break;
              ugemm_unit(P, u / 288, u % 288, lds); } }
    }
    for (int l = 0; l < 2; ++l) {
        const int k0 = 2 + 9 * l;
        unsigned char* WL = wl(P, l);
        if (RUN(2, k0 + 0)) for (int rep_ = 0; rep_ < REPS(2); ++rep_) { if (rep_) xcd_barrier(bar); const Frame F = mk_frame(lds);
            pg8::Gemm g{(const bf16_t*)(P.ws + WS_XB), (const bf16_t*)(WL + WL_WIN), 1024, 1024, 1024};
            { LAS float* gt = (LAS float*)(lds + LDS_GT);
              for (int i = F.tid; i < 320; i += 512) gt[i] = i < 64 ? P.q_norm[l * 64 + i] : i < 128 ? P.k_norm[(l * 3 + 1) * 64 + i - 64] : i < 192 ? P.k_norm[(l * 3 + 2) * 64 + i - 128] : P.mem_q_norm[l * 128 + i - 192];
              __syncthreads(); }
            EpiInprojF E{(bf16_t*)(P.ws + WS_H), l == 0 ? (const float*)(P.ws + WS_RINV) : (const float*)(P.ws + WS_SSQ) + 2 * SSQ_STRIDE, (LAS float*)(lds + LDS_XS), (const LAS float*)(lds + LDS_GT), l,
                          (bf16_t*)(P.ws + WS_QC), (bf16_t*)(P.ws + WS_QR), (bf16_t*)(P.ws + WS_KS), (bf16_t*)(P.ws + WS_KW), (bf16_t*)(P.ws + WS_VST), (bf16_t*)(P.ws + WS_VWT), (bf16_t*)(P.ws + WS_MQ), P.out};
            if (F.G == 256) { pg8::SchedInprojBal S{F.cu, (size_t)256 * 1024 * 2, (size_t)256 * 1024 * 2}; pg8::gemm_phase(lds, g, S, E); }
            else { pg8::SchedMN S{64, 26, F.G, F.cu, (size_t)256 * 1024 * 2, (size_t)256 * 1024 * 2}; pg8::gemm_phase(lds, g, S, E); }
            if (2 * F.cu >= F.G) {
                for (int it = F.G - 1 - F.cu; it < 208; it += F.G / 2) s_inproj_item(P, l, it, lds);
                if (l == 0) { const Frame F2 = mk_frame(lds); LAS float* scr = (LAS float*)(lds + F2.wave * 16384); __syncthreads();
                    for (int it = (F2.G - 1 - F2.cu) * 8 + F2.wave; it < WI_LATE / 4; it += (F2.G / 2) * 8) weight_item(P, 1, it, scr, F2.lane); }
            }
        }
        SEAM(k0 + 0);
        if (RUN(3, k0 + 1)) for (int rep_ = 0; rep_ < REPS(3); ++rep_) { if (rep_) xcd_barrier(bar); const Frame F = mk_frame(lds);
            for (int it = F.gw; it < 1024; it += F.ngw) cmpu_wave(P, l, it, F.lane);
            { const Frame F2 = mk_frame(lds); LAS bf16_t* vt = (LAS bf16_t*)(lds + 65536 + F2.wave * 4096);
              for (int sr_ = 0; sr_ < SUBREPS(1); ++sr_) for (int blk = F2.gw; blk < MP / 8; blk += F2.ngw) post_conv8(P, l, 8 * blk, F2.lane); (void)vt; }
            { const Frame F2 = mk_frame(lds); for (int m = MP + (F2.ngw - 1 - F2.gw); m < MP + MS; m += F2.ngw) post_row(P, l, m, F2.lane); }
            { const Frame F2 = mk_frame(lds); for (int blk = F2.ngw - 1 - F2.gw; blk < 2336; blk += F2.ngw) wincopy_rows(P, l, blk, F2.lane); }
            if (l == 0) {
                { const Frame F2 = mk_frame(lds); for (int it = F2.gw; it < 2048; it += F2.ngw) memkv_row(P, it, F2.lane); }
            }
        }
        SEAM(k0 + 1);
        if (RUN(4, k0 + 2)) for (int rep_ = 0; rep_ < REPS(4); ++rep_) { if (rep_) xcd_barrier(bar); const Frame F = mk_frame(lds);
            if (F.G == 256) { if (F.cu >= 128 && F.cu < 192) for (int it = (F.cu - 128) * 8 + F.wave; it < 256; it += 512) cmpp_task(P, l, it, F.lane); }
            else for (int it = F.gw; it < 256; it += F.ngw) cmpp_task(P, l, it, F.lane);
            {
              const int q = F.G / 4, cls = F.cu / q, r = F.cu - cls * q;
              if (cls < 3 && F.cu < 256) mem_unit(P, l, F.cu >> 6, (F.cu >> 4) & 3, F.cu & 15, lds);
              if (cls == 0) for (int u = 3 * q + r; u < 256; u += q) mem_unit(P, l, u >> 6, (u >> 4) & 3, u & 15, lds);
              if (cls == 1) { for (int s = r; s < 64; s += q) sample_win_unit(P, l, s >> 1, s & 1, lds); for (int s = r; s < 64; s += q) sample_mem_unit(P, l, s >> 2, s & 3, lds); }
              if (cls == 2) for (int s = 64 + r; s < 128; s += q) sample_mem_unit(P, l, s >> 2, s & 3, lds);
              if (cls >= 3) for (int s = F.cu - 3 * q; s < 64; s += F.G - 3 * q) sample_nsa_unit(P, l, s >> 1, s & 1, lds); }
        }
        SEAM(k0 + 2);
        if (RUN(5, k0 + 3)) for (int rep_ = 0; rep_ < REPS(5); ++rep_) { if (rep_) xcd_barrier(bar); const Frame F = mk_frame(lds);
            for (int u = F.cu; u < 512; u += F.G) { const int r = u & 255, bg = r & 7, s = r >> 3, qb = (u < 256) ? 63 - s : s;
                const unsigned long long sel = cmp_unit(P, bg >> 1, bg & 1, qb, lds);
                nsa_unit(P, l, bg >> 1, bg & 1, qb, lds, sel); }
            { const Frame F2 = mk_frame(lds); for (int b = F2.gw; b < 32; b += F2.ngw) sample_combine_row(P, b, F2.lane); }
        }
        SEAM(k0 + 3);
        if (RUN(7, k0 + 5)) for (int rep_ = 0; rep_ < REPS(7); ++rep_) { if (rep_) xcd_barrier(bar); const Frame F = mk_frame(lds);
            pg8::Gemm g{(const bf16_t*)(P.ws + WS_BR), (const bf16_t*)(WL + WL_WBR), 1536, 1536, 512};
            pg8::SchedBranch S{64, 4, F.G, F.cu, (size_t)256 * 1536 * 2, (size_t)256 * 1536 * 2};
            EpiBranch E{(bf16_t*)(P.ws + WS_MG), (const bf16_t*)(P.ws + WS_H)};
            pg8::gemm_phase(lds, g, S, E);
            for (int it = F.G - 1 - F.cu; it < 32; it += F.G) s_branch_item(P, l, it, lds);
        }
        SEAM(k0 + 5);
        if (RUN(8, k0 + 6)) for (int rep_ = 0; rep_ < REPS(8); ++rep_) { if (rep_) xcd_barrier(bar); const Frame F = mk_frame(lds);
            pg8::Gemm g{(const bf16_t*)(P.ws + WS_MG), (const bf16_t*)(WL + WL_WOUT), 1024, 1024, 1024};
            pg8::SchedMN S{64, 4, F.G, F.cu, (size_t)256 * 1024 * 2, (size_t)256 * 1024 * 2};
            EpiResidual E{l == 0 ? P.x_prompt : (const float*)(P.ws + WS_XNEXT), (float*)(P.ws + WS_HRES), rep_ ? (bf16_t*)nullptr : (bf16_t*)(P.ws + WS_HB), (float*)(P.ws + WS_SSQ) + (size_t)l * SSQ_STRIDE};
            pg8::gemm_phase(lds, g, S, E);
            if (rep_ == 0) for (int it = F.G - 1 - F.cu; it < 32; it += F.G) s_wout_item(P, l, it, lds);
        }
        SEAM(k0 + 6);
        if (RUN(9, k0 + 7)) for (int rep_ = 0; rep_ < REPS(9); ++rep_) { if (rep_) xcd_barrier(bar); const Frame F = mk_frame(lds);
            pg8::Gemm g{(const bf16_t*)(P.ws + WS_HB), (const bf16_t*)(WL + WL_WGU), 1024, 1024, 1024};
            pg8::SchedMN S{64, 22, F.G, F.cu, (size_t)256 * 1024 * 2, (size_t)256 * 1024 * 2};
            EpiGateUp E{(bf16_t*)(P.ws + WS_ACT), (const float*)(P.ws + WS_SSQ) + (size_t)l * SSQ_STRIDE};
            pg8::gemm_phase(lds, g, S, E);
            if (2 * F.cu >= F.G) {
                for (int it = F.G - 1 - F.cu; it < 176; it += F.G / 2) s_gateup_item(P, l, it, lds);
                if (l == 0) { const Frame F2 = mk_frame(lds); LAS float* scr = (LAS float*)(lds + F2.wave * 16384); __syncthreads();
                    for (int it = WI_LATE / 4 + (F2.G - 1 - F2.cu) * 8 + F2.wave; it < WI_LATE; it += (F2.G / 2) * 8) weight_item(P, 1, it, scr, F2.lane); }
            }
        }
        SEAM(k0 + 7);
        if (RUN(10, k0 + 8)) for (int rep_ = 0; rep_ < REPS(10); ++rep_) { if (rep_) xcd_barrier(bar); const Frame F = mk_frame(lds);
            pg8::Gemm g{(const bf16_t*)(P.ws + WS_ACT), (const bf16_t*)(WL + WL_WDN), D_FF, D_FF, D_FF};
            pg8::SchedMN S{64, 4, F.G, F.cu, (size_t)256 * D_FF * 2, (size_t)256 * D_FF * 2};
            EpiResidual E{(const float*)(P.ws + WS_HRES), l == 0 ? (float*)(P.ws + WS_XNEXT) : P.out + O_Y, (l == 0 && rep_ == 0) ? (bf16_t*)(P.ws + WS_XB) : (bf16_t*)nullptr, (float*)(P.ws + WS_SSQ) + 2 * SSQ_STRIDE};
            pg8::gemm_phase(lds, g, S, E);
            if (rep_ == 0) for (int it = F.G - 1 - F.cu; it < 32; it += F.G) s_down_item(P, l, it, lds);
        }
        if (l == 0) SEAM(k0 + 8);
    }
#if defined(PROBE_BARRIERS)
    for (int i_ = 0; i_ < PROBE_BARRIERS; ++i_) xcd_barrier(bar);
#endif
#undef RUN
#undef INW
#undef SEAM
}

extern "C" void kernel_launch(void* const* d_in, const int* in_sizes, int n_in, void* d_out, int out_size, void* d_ws, size_t ws_size, hipStream_t stream) {
    static int grid = 0;
    if (grid == 0) {
        if (n_in != 25 || (size_t)out_size != O_TOTAL || ws_size < WS_END) { fprintf(stderr, "kernel_launch: unexpected shapes (n_in %d, out %d, ws %zu < %zu)\n", n_in, out_size, ws_size, (size_t)WS_END); grid = -1; return; }
        int dev = 0, cus = 0, per_cu = 0;
        if (hipGetDevice(&dev) != hipSuccess || hipDeviceGetAttribute(&cus, hipDeviceAttributeMultiprocessorCount, dev) != hipSuccess) { grid = -1; return; }
#if N_LAUNCH_MODE == 0
        if (hipFuncSetAttribute((const void*)mega<0x7FFu>, hipFuncAttributeMaxDynamicSharedMemorySize, LDS_BYTES) != hipSuccess) { fprintf(stderr, "kernel_launch: hipFuncSetAttribute failed\n"); grid = -1; return; }
        if (hipOccupancyMaxActiveBlocksPerMultiprocessor(&per_cu, (const void*)mega<0x7FFu>, 512, LDS_BYTES) != hipSuccess || per_cu < 1) fprintf(stderr, "kernel_launch: occupancy query says %d\n", per_cu);
#else
#define LATTR(s) if (hipFuncSetAttribute((const void*)mega<(1u << s)>, hipFuncAttributeMaxDynamicSharedMemorySize, LDS_BYTES) != hipSuccess) { fprintf(stderr, "kernel_launch: hipFuncSetAttribute failed\n"); grid = -1; return; }
        LATTR(0) LATTR(1) LATTR(2) LATTR(3) LATTR(4) LATTR(5) LATTR(6) LATTR(7) LATTR(8) LATTR(9) LATTR(10)
#undef LATTR
        per_cu = 1;
#endif
        (void)hipGetLastError();
        grid = cus;
    }
    if (grid < 0) return;
    (void)hipMemsetAsync((char*)d_ws + WS_CTL, 0, CTL_BYTES, stream);
    Params p{};
    p.x_prompt = (const float*)d_in[0]; p.x_sample = (const float*)d_in[1]; p.cache_nsa = (const float*)d_in[2]; p.cache_win = (const float*)d_in[3];
    p.state_conv = (const float*)d_in[4]; p.cache_mem = (const float*)d_in[5]; p.page_table = (const int*)d_in[6]; p.mem_prompt = (const float*)d_in[7];
    p.norm_mix = (const float*)d_in[8]; p.w_in = (const float*)d_in[9]; p.q_norm = (const float*)d_in[10]; p.k_norm = (const float*)d_in[11];
    p.cmp_pe = (const float*)d_in[12]; p.cmp_w1 = (const float*)d_in[13]; p.cmp_w2 = (const float*)d_in[14]; p.conv_w = (const float*)d_in[15];
    p.norm_mem = (const float*)d_in[16]; p.w_mem_kv = (const float*)d_in[17]; p.mem_q_norm = (const float*)d_in[18]; p.mem_k_norm = (const float*)d_in[19];
    p.w_branch = (const float*)d_in[20]; p.w_out = (const float*)d_in[21]; p.norm_ffn = (const float*)d_in[22]; p.w_gate_up = (const float*)d_in[23]; p.w_down = (const float*)d_in[24];
    p.out = (float*)d_out; p.ws = (unsigned char*)d_ws;
#if N_LAUNCH_MODE == 0
    p.ph_lo = 0; p.ph_hi = NPHASE; p.li = 0; p.pad = 0;
    hipLaunchKernelGGL(mega<0x7FFu>, dim3(grid), dim3(512), LDS_BYTES, stream, p);
#else
    for (int k = 0; k < NPHASE; ++k) { p.ph_lo = k; p.ph_hi = k + 1; p.li = k; p.pad = 0; const int site = k < 2 ? k : 2 + (k - 2) % 9;
        switch (site) {
#define LCASE(s) case s: hipLaunchKernelGGL(mega<(1u << s)>, dim3(grid), dim3(512), LDS_BYTES, stream, p); break;
            LCASE(0) LCASE(1) LCASE(2) LCASE(3) LCASE(4) LCASE(5) LCASE(6) LCASE(7) LCASE(8) LCASE(9) LCASE(10)
#undef LCASE
        } }
#endif
    if (hipPeekAtLastError() != hipSuccess) fprintf(stderr, "kernel_launch: launch failed: %s\n", hipGetErrorName(hipGetLastError()));
}
```
